# Optimizing an MI355X kernel written in HIP

```python
import math
import jax
import jax.numpy as jnp
from jax import lax
import numpy as np

D_MODEL = 1024
BATCH = 32
SEQ = 2048
DEPTH = 1

N_HEADS = 8
N_KV_GROUPS = 2
HEADS_PER_GROUP = N_HEADS // N_KV_GROUPS
HEAD_DIM = 64
ATTN_WIDTH = N_HEADS * HEAD_DIM
KV_WIDTH = N_KV_GROUPS * HEAD_DIM
N_KV_SLOTS = 6
ROPE_DIM = HEAD_DIM // 4
ROPE_THETA = 500000.0
CMP_BLOCK = 32
CMP_STRIDE = 16
CMP_HIDDEN = 4 * HEAD_DIM
SEL_BLOCK = 64
N_SEL_BLOCKS = 16
WINDOW = 512
WIN_QBLOCK = 128
SEL_QBLOCK = 16
CONV_WIDTH = 512
CONV_KERNEL = 3
D_FF = 2816
N_BRANCHES = 2
W_IN_SIZES = (ATTN_WIDTH, N_KV_SLOTS * KV_WIDTH, 3 * N_HEADS, 3 * CONV_WIDTH, N_BRANCHES * D_MODEL)
W_IN_COLS = ATTN_WIDTH + N_KV_SLOTS * KV_WIDTH + 3 * N_HEADS + 3 * CONV_WIDTH + N_BRANCHES * D_MODEL

NORM_EPS = 1e-6
MASK_VALUE = -1e30
FORCE_SCORE = 1e4

kernel_name = "hybrid_nsa_shortconv_macaron"


def rms_norm(x, g):
    x32 = x.astype(jnp.float32)
    y = x32 * lax.rsqrt(jnp.mean(x32 * x32, axis=-1, keepdims=True) + NORM_EPS)
    return y.astype(x.dtype) * g


def swiglu(x, w_gate, w_up, w_down):
    return (jax.nn.silu(x @ w_gate) * (x @ w_up)) @ w_down


def partial_rope(x, pos):
    half = ROPE_DIM // 2
    inv_freq = ROPE_THETA ** (-jnp.arange(0, ROPE_DIM, 2, dtype=jnp.float32) / ROPE_DIM)
    ang = pos.astype(jnp.float32)[:, None] * inv_freq[None, :]
    cos = jnp.cos(ang)[:, None, :]
    sin = jnp.sin(ang)[:, None, :]
    xr = x[..., :ROPE_DIM].astype(jnp.float32)
    x1, x2 = xr[..., :half], xr[..., half:]
    rot = jnp.concatenate([x1 * cos - x2 * sin, x2 * cos + x1 * sin], axis=-1)
    return jnp.concatenate([rot.astype(x.dtype), x[..., ROPE_DIM:]], axis=-1)


def compress(t, pe, w1, w2):
    b, s, g, d = t.shape
    n_chunks = s // CMP_STRIDE
    n_per = CMP_BLOCK // CMP_STRIDE
    nb = n_chunks - n_per + 1
    chunks = t.reshape(b, n_chunks, CMP_STRIDE, g, d)
    blocks = jnp.concatenate([chunks[:, j:j + nb] for j in range(n_per)], axis=2)
    blocks = blocks + pe[None, None, :, None, :]
    flat = blocks.transpose(0, 1, 3, 2, 4).reshape(b, nb, g, CMP_BLOCK * d)
    return jax.nn.silu(flat @ w1) @ w2


def compressed_attention(q, k_c, v_c, pos):
    nb = k_c.shape[2]
    cmp_end = jnp.arange(nb) * CMP_STRIDE + CMP_BLOCK - 1
    valid = cmp_end[None, :] <= pos[:, None]
    s = jnp.einsum('bghsd,bgnd->bghsn', q, k_c).astype(jnp.float32) * (HEAD_DIM ** -0.5)
    p = jax.nn.softmax(jnp.where(valid, s, MASK_VALUE), axis=-1) * valid.astype(jnp.float32)
    o = jnp.einsum('bghsn,bgnd->bghsd', p.astype(v_c.dtype), v_c)
    return o, p


def select_blocks(p_c, pos):
    s = pos.shape[0]
    nb = p_c.shape[-1]
    nsb = s // SEL_BLOCK
    k_eff = min(N_SEL_BLOCKS, nsb)
    cs = jnp.arange(nb) * CMP_STRIDE
    ce = cs + CMP_BLOCK
    ss = jnp.arange(nsb) * SEL_BLOCK
    se = ss + SEL_BLOCK
    overlap = ((cs[:, None] < se[None, :]) & (ce[:, None] > ss[None, :])).astype(jnp.float32)
    imp = jnp.einsum('bghsn,nj->bgsj', p_c, overlap)
    j = jnp.arange(nsb)[None, :]
    cur = (pos // SEL_BLOCK)[:, None]
    forced = (j == 0) | (j == cur) | (j == cur - 1)
    future = ss[None, :] > pos[:, None]
    imp = jnp.where(forced, FORCE_SCORE, jnp.where(future, -1.0, imp))
    _, idx = lax.top_k(imp, k_eff)
    return idx


def selected_attention(q, k_s, v_s, sel_idx):
    b, g, hp, s, d = q.shape
    kk = sel_idx.shape[-1]
    nsb = s // SEL_BLOCK
    n_qc = s // SEL_QBLOCK
    k_blk = k_s.reshape(b, g, nsb, SEL_BLOCK, d)
    v_blk = v_s.reshape(b, g, nsb, SEL_BLOCK, d)
    q_ch = q.reshape(b, g, hp, n_qc, SEL_QBLOCK, d).transpose(3, 0, 1, 2, 4, 5)
    i_ch = sel_idx.reshape(b, g, n_qc, SEL_QBLOCK, kk).transpose(2, 0, 1, 3, 4)
    starts = jnp.arange(n_qc) * SEL_QBLOCK
    b_ix = jnp.arange(b)[:, None, None, None]
    g_ix = jnp.arange(g)[None, :, None, None]

    def step(args):
        qc, ic, st = args
        kg = k_blk[b_ix, g_ix, ic]
        vg = v_blk[b_ix, g_ix, ic]
        sc = jnp.einsum('bghqd,bgqkld->bghqkl', qc, kg).astype(jnp.float32) * (HEAD_DIM ** -0.5)
        kpos = ic[..., None] * SEL_BLOCK + jnp.arange(SEL_BLOCK)
        qpos = st + jnp.arange(SEL_QBLOCK)
        valid = kpos <= qpos[None, None, :, None, None]
        sc = jnp.where(valid[:, :, None], sc, MASK_VALUE).reshape(b, g, hp, SEL_QBLOCK, kk * SEL_BLOCK)
        p = jax.nn.softmax(sc, axis=-1).reshape(b, g, hp, SEL_QBLOCK, kk, SEL_BLOCK)
        return jnp.einsum('bghqkl,bgqkld->bghqd', p.astype(vg.dtype), vg)

    o = lax.map(step, (q_ch, i_ch, starts))
    return o.transpose(1, 2, 3, 0, 4, 5).reshape(b, g, hp, s, d)


def window_attention(q, k_w, v_w):
    b, g, hp, s, d = q.shape
    n_wb = s // WIN_QBLOCK
    span = WINDOW + WIN_QBLOCK
    k_pad = jnp.pad(k_w, ((0, 0), (0, 0), (WINDOW, 0), (0, 0)))
    v_pad = jnp.pad(v_w, ((0, 0), (0, 0), (WINDOW, 0), (0, 0)))
    q_bl = q.reshape(b, g, hp, n_wb, WIN_QBLOCK, d).transpose(3, 0, 1, 2, 4, 5)
    starts = jnp.arange(n_wb) * WIN_QBLOCK

    def step(args):
        qb, st = args
        kb = lax.dynamic_slice_in_dim(k_pad, st, span, axis=2)
        vb = lax.dynamic_slice_in_dim(v_pad, st, span, axis=2)
        sc = jnp.einsum('bghqd,bgkd->bghqk', qb, kb).astype(jnp.float32) * (HEAD_DIM ** -0.5)
        kpos = st - WINDOW + jnp.arange(span)
        qpos = st + jnp.arange(WIN_QBLOCK)
        diff = qpos[:, None] - kpos[None, :]
        valid = (kpos[None, :] >= 0) & (diff >= 0) & (diff < WINDOW)
        p = jax.nn.softmax(jnp.where(valid, sc, MASK_VALUE), axis=-1)
        return jnp.einsum('bghqk,bgkd->bghqd', p.astype(vb.dtype), vb)

    o = lax.map(step, (q_bl, starts))
    return o.transpose(1, 2, 3, 0, 4, 5).reshape(b, g, hp, s, d)


def nsa_mixer(q, kv, gate_logits, q_norm_g, k_norm_g, cmp_pe_k, cmp_pe_v,
              cmp_k_w1, cmp_k_w2, cmp_v_w1, cmp_v_w2):
    b, s, _ = q.shape
    pos = jnp.arange(s)
    q = partial_rope(rms_norm(q.reshape(b, s, N_HEADS, HEAD_DIM), q_norm_g), pos)
    q = q.reshape(b, s, N_KV_GROUPS, HEADS_PER_GROUP, HEAD_DIM).transpose(0, 2, 3, 1, 4)
    kv = kv.reshape(b, s, N_KV_SLOTS, N_KV_GROUPS, HEAD_DIM)
    k_c = rms_norm(compress(kv[:, :, 0], cmp_pe_k, cmp_k_w1, cmp_k_w2), k_norm_g[0]).transpose(0, 2, 1, 3)
    v_c = compress(kv[:, :, 1], cmp_pe_v, cmp_v_w1, cmp_v_w2).transpose(0, 2, 1, 3)
    k_s = partial_rope(rms_norm(kv[:, :, 2], k_norm_g[1]), pos).transpose(0, 2, 1, 3)
    v_s = kv[:, :, 3].transpose(0, 2, 1, 3)
    k_w = partial_rope(rms_norm(kv[:, :, 4], k_norm_g[2]), pos).transpose(0, 2, 1, 3)
    v_w = kv[:, :, 5].transpose(0, 2, 1, 3)

    o_c, p_c = compressed_attention(q, k_c, v_c, pos)
    sel_idx = select_blocks(p_c, pos)
    o_s = selected_attention(q, k_s, v_s, sel_idx)
    o_w = window_attention(q, k_w, v_w)

    gts = jax.nn.sigmoid(gate_logits.reshape(b, s, 3, N_KV_GROUPS, HEADS_PER_GROUP).astype(jnp.float32))
    gts = gts.astype(q.dtype).transpose(2, 0, 3, 4, 1)[..., None]
    o = gts[0] * o_c + gts[1] * o_s + gts[2] * o_w
    return o.transpose(0, 3, 1, 2, 4).reshape(b, s, ATTN_WIDTH)


def short_conv_mixer(cv):
    return jnp.split(cv, 3, axis=-1)


def setup_inputs(seed: int = 0) -> dict:
    key = jax.random.key(seed)
    ks = jax.random.split(key, 24)
    L = DEPTH

    def nrm(k, shape, fan_in):
        return jax.random.normal(k, shape, jnp.float32) * (fan_in ** -0.5)

    def gain(k, shape):
        return 1.0 + 0.02 * jax.random.normal(k, shape, jnp.float32)

    return {
        "x": jax.random.normal(ks[0], (BATCH, SEQ, D_MODEL), jnp.float32),
        "ffn1_norm_g": gain(ks[1], (L, D_MODEL)),
        "ffn1_w_gate": nrm(ks[2], (L, D_MODEL, D_FF), D_MODEL),
        "ffn1_w_up": nrm(ks[3], (L, D_MODEL, D_FF), D_MODEL),
        "ffn1_w_down": nrm(ks[4], (L, D_FF, D_MODEL), D_FF),
        "mix_norm_g": gain(ks[5], (L, D_MODEL)),
        "w_in": nrm(ks[6], (L, D_MODEL, W_IN_COLS), D_MODEL),
        "q_norm_g": gain(ks[7], (L, HEAD_DIM)),
        "k_norm_g": gain(ks[8], (L, 3, HEAD_DIM)),
        "cmp_pe_k": 0.1 * jax.random.normal(ks[9], (L, CMP_BLOCK, HEAD_DIM), jnp.float32),
        "cmp_pe_v": 0.1 * jax.random.normal(ks[10], (L, CMP_BLOCK, HEAD_DIM), jnp.float32),
        "cmp_k_w1": nrm(ks[11], (L, CMP_BLOCK * HEAD_DIM, CMP_HIDDEN), CMP_BLOCK * HEAD_DIM),
        "cmp_k_w2": nrm(ks[12], (L, CMP_HIDDEN, HEAD_DIM), CMP_HIDDEN),
        "cmp_v_w1": nrm(ks[13], (L, CMP_BLOCK * HEAD_DIM, CMP_HIDDEN), CMP_BLOCK * HEAD_DIM),
        "cmp_v_w2": nrm(ks[14], (L, CMP_HIDDEN, HEAD_DIM), CMP_HIDDEN),
        "conv_w": nrm(ks[15], (L, CONV_KERNEL, CONV_WIDTH), CONV_KERNEL),
        "w_attn_branch": nrm(ks[16], (L, ATTN_WIDTH, D_MODEL), ATTN_WIDTH),
        "w_conv_branch": nrm(ks[17], (L, CONV_WIDTH, D_MODEL), CONV_WIDTH),
        "w_out": nrm(ks[18], (L, D_MODEL, D_MODEL), D_MODEL),
        "ffn2_norm_g": gain(ks[19], (L, D_MODEL)),
        "ffn2_w_gate": nrm(ks[20], (L, D_MODEL, D_FF), D_MODEL),
        "ffn2_w_up": nrm(ks[21], (L, D_MODEL, D_FF), D_MODEL),
        "ffn2_w_down": nrm(ks[22], (L, D_FF, D_MODEL), D_FF),
    }


def reference(x, ffn1_norm_g, ffn1_w_gate, ffn1_w_up, ffn1_w_down, mix_norm_g, w_in,
              q_norm_g, k_norm_g, cmp_pe_k, cmp_pe_v, cmp_k_w1, cmp_k_w2, cmp_v_w1, cmp_v_w2,
              conv_w, w_attn_branch, w_conv_branch, w_out,
              ffn2_norm_g, ffn2_w_gate, ffn2_w_up, ffn2_w_down):
    split_at = [int(v) for v in np.cumsum(W_IN_SIZES)[:-1]]
    for l in range(DEPTH):
        x = x + 0.5 * swiglu(rms_norm(x, ffn1_norm_g[l]), ffn1_w_gate[l], ffn1_w_up[l], ffn1_w_down[l])

        h = rms_norm(x, mix_norm_g[l])
        proj = h @ w_in[l]
        q, kv, nsa_gl, cv, merge_gl = jnp.split(proj, split_at, axis=-1)

        a = nsa_mixer(q, kv, nsa_gl, q_norm_g[l], k_norm_g[l], cmp_pe_k[l], cmp_pe_v[l],
                      cmp_k_w1[l], cmp_k_w2[l], cmp_v_w1[l], cmp_v_w2[l])

        gate_b, gate_c, u = short_conv_mixer(cv)
        conv = lax.conv_general_dilated(
            gate_c * u, conv_w[l][:, None, :], window_strides=(1,),
            padding=[(CONV_KERNEL - 1, 0)], dimension_numbers=('NWC', 'WIO', 'NWC'),
            feature_group_count=CONV_WIDTH)
        c = gate_b * conv

        mg = jax.nn.sigmoid(merge_gl.astype(jnp.float32)).astype(x.dtype)
        g_a, g_c = mg[..., :D_MODEL], mg[..., D_MODEL:]
        merged = g_a * (a @ w_attn_branch[l]) + g_c * (c @ w_conv_branch[l])
        x = x + merged @ w_out[l]

        x = x + 0.5 * swiglu(rms_norm(x, ffn2_norm_g[l]), ffn2_w_gate[l], ffn2_w_up[l], ffn2_w_down[l])
    return x
```

```cpp
#include <hip/hip_runtime.h>
#include <hip/hip_cooperative_groups.h>
#include <cstdio>
#include <cstdint>
namespace cg = cooperative_groups;

#ifndef MK_N_LAUNCHES
#define MK_N_LAUNCHES 1
#endif

#define DI __device__ __forceinline__
#define LAS __attribute__((address_space(3)))
typedef unsigned short bf16_t;
typedef short bf16x8 __attribute__((ext_vector_type(8)));
typedef float f32x4 __attribute__((ext_vector_type(4)));
typedef float f32x16 __attribute__((ext_vector_type(16)));
typedef unsigned u32x4 __attribute__((ext_vector_type(4)));
typedef unsigned u32x2 __attribute__((ext_vector_type(2)));
typedef float f32x2_t __attribute__((ext_vector_type(2)));
typedef __bf16 bf16x2_t __attribute__((ext_vector_type(2)));

DI unsigned pk2(float lo, float hi) { f32x2_t v = {lo, hi}; bf16x2_t b = __builtin_convertvector(v, bf16x2_t); return __builtin_bit_cast(unsigned, b); }
DI float bf_lo(unsigned u) { return __uint_as_float(u << 16); }
DI float bf_hi(unsigned u) { return __uint_as_float(u & 0xffff0000u); }
DI float fast_exp2(float x) { return __builtin_amdgcn_exp2f(x); }
DI float fast_rcp(float x) { return __builtin_amdgcn_rcpf(x); }
DI float sigmoidf_(float x) { return fast_rcp(1.f + fast_exp2(-1.4426950408889634f * x)); }
DI float siluf_(float x) { return x * sigmoidf_(x); }
DI float wave_sum(float v) {
#pragma unroll
    for (int o = 1; o < 64; o <<= 1) v += __shfl_xor(v, o);
    return v;
}

constexpr int SEQ = 2048, DM = 1024, MTOK = 65536, FF = 2816, NGU = 5632, NWIN = 5120;
constexpr float NORM_EPS = 1e-6f;
constexpr float QSCALE = 0.125f * 1.4426950408889634f;
constexpr size_t KV_SLOT = (size_t)MTOK * 64 * 2;

constexpr size_t MiB = 1u << 20;
constexpr size_t WS_ROPE = 1 * MiB, WS_BIAS1 = 1 * MiB + 256 * 1024;
constexpr size_t WS_WGU1 = 2 * MiB, WS_WD1 = 13 * MiB, WS_WIN = 19 * MiB, WS_WA = 29 * MiB, WS_WC = 30 * MiB, WS_WOUT = 31 * MiB;
constexpr size_t WS_WGU2 = 33 * MiB, WS_WD2 = 44 * MiB, WS_WCK1 = 50 * MiB, WS_WCV1 = 51 * MiB, WS_SSP = 52 * MiB;
constexpr size_t WS_XB = 64 * MiB, WS_BIG = 192 * MiB;
constexpr size_t WS_HID = WS_BIG, WS_Q = WS_BIG, WS_KV = WS_BIG + 64 * MiB, WS_PCU = WS_BIG + 162 * MiB, WS_GB = WS_BIG + 226 * MiB;
constexpr size_t WS_MG = WS_BIG + 290 * MiB, WS_NG = WS_BIG + 546 * MiB, WS_AO = WS_BIG + 552 * MiB, WS_HC = WS_BIG + 616 * MiB;
constexpr size_t WS_KCC = WS_BIG + 624 * MiB, WS_VCC = WS_BIG + 625 * MiB, WS_MERGED = WS_BIG;
constexpr size_t WS_END = WS_BIG + 626 * MiB;

namespace pg8 {
constexpr int BM = 256, BK = 64, HALF = 128, HTB = HALF * BK * 2, STAGE_BYTES = 8 * HTB, NXCD = 8, WGM = 8;
DI int lds_byte(int r, int c) { const int st = (r >> 4) * 2 + (c >> 5), rr = r & 15, cc = c & 31, ob = rr * 64 + cc * 2; return st * 1024 + (ob ^ (((ob >> 9) & 1) << 5)); }
DI void stage_rc(int b, int& R, int& C) { const int st = b / 1024, sb = b % 1024, swz = sb ^ (((sb >> 9) & 1) << 5); R = (st >> 1) * 16 + swz / 64; C = (st & 1) * 32 + (swz % 64) / 2; }
DI int perm32(int rho) { const int n = rho >> 4, i = rho & 15; return 8 * (i >> 2) + 4 * n + (i & 3); }

struct Unit { int pm, pn, src; };
struct Gemm { const bf16_t* A0; const bf16_t* A1; const bf16_t* B0; const bf16_t* B1; int lda, ldb, K; };

template <bool CHAIN> struct StaticOrder {
    int nM, nN, nwg, G, c;
    DI void init(int M, int N, int G_, int c_) { nM = M / BM; nN = N / BM; nwg = nM * nN; G = G_; c = c_; }
    DI bool next(int i, Unit& u) const {
        const int it = CHAIN ? (i >> 1) : i; u.src = CHAIN ? (i & 1) : 0;
        const long L = (long)it * G + c; if (L >= nwg) return false;
        int wgid = (int)L; { const int q = nwg / NXCD, r = nwg % NXCD, xcd = wgid % NXCD, off = wgid / NXCD; wgid = (xcd < r ? xcd * (q + 1) : r * (q + 1) + (xcd - r) * q) + off; }
        const int nig = WGM * nN, gid = wgid / nig, fm = gid * WGM, gsz = (nM - fm) < WGM ? (nM - fm) : WGM;
        u.pm = fm + ((wgid % nig) % gsz); u.pn = (wgid % nig) / gsz; return true;
    }
};
struct CmpOrder {
    int c;
    DI bool next(int i, Unit& u) const { if (i > 0 || c >= 64) return false; u.pm = c & 31; u.pn = 0; u.src = c >> 5; return true; }
};

template <class Epi, class Sched>
DI void gemm_phase(LAS unsigned char* lds, const Gemm g, const Sched& S, const Epi& E) {
    const int tid = threadIdx.x, wid = __builtin_amdgcn_readfirstlane(tid >> 6), lane = tid & 63, wr = wid >> 2, wc = wid & 3, fr = lane & 15, fq = lane >> 4;
    const int K = g.K, nt = K / BK;
    unsigned voffA[2], voffB[2];
#pragma unroll
    for (int i = 0; i < 2; ++i) { int R, C; stage_rc(tid * 16 + i * 8192, R, C); const int Rb = Epi::PERM ? ((R & ~31) + perm32(R & 31)) : R;
        voffA[i] = (unsigned)(R * g.lda + C) * 2u; voffB[i] = (unsigned)(Rb * g.ldb + C) * 2u; }
    const size_t kstep = (size_t)(BK * 2);
    const size_t hstepA = (size_t)HALF * g.lda * 2, hstepB = (size_t)HALF * g.ldb * 2;
    const size_t tstepA = 2 * hstepA, tstepB = 2 * hstepB;
    const unsigned ldsw = (unsigned)wid * 1024u;
    const int aoff = lds_byte(wr * 64 + fr, fq * 8), boff = lds_byte(wc * 32 + fr, fq * 8);
#define PG8_SA(b, h) (((b) * 2 + (h)) * HTB)
#define PG8_SB(b, h) ((4 + (b) * 2 + (h)) * HTB)
#define PG8_STAGE(bufoff, gbase, voff) do { _Pragma("unroll") for (int _i = 0; _i < 2; ++_i) \
        __builtin_amdgcn_global_load_lds((const unsigned*)((const char*)(gbase) + (voff)[_i]), (LAS unsigned*)(lds + (bufoff) + ldsw + _i * 8192), 16, 0, 0); } while (0)
#define PG8_LDA(dst, b, h) do { _Pragma("unroll") for (int m = 0; m < 4; ++m) _Pragma("unroll") for (int k = 0; k < 2; ++k) dst[m][k] = *(const LAS bf16x8*)(lds + PG8_SA(b, h) + aoff + m * 2048 + k * 1024); } while (0)
#define PG8_LDB(dst, b, h) do { _Pragma("unroll") for (int n = 0; n < 2; ++n) _Pragma("unroll") for (int k = 0; k < 2; ++k) dst[n][k] = *(const LAS bf16x8*)(lds + PG8_SB(b, h) + boff + n * 2048 + k * 1024); } while (0)
#define PG8_MMA(ai, bj, At, Bt) do { __builtin_amdgcn_s_setprio(1); _Pragma("unroll") for (int m = 0; m < 4; ++m) _Pragma("unroll") for (int n = 0; n < 2; ++n) _Pragma("unroll") for (int k = 0; k < 2; ++k) \
        acc[ai][bj][m][n] = __builtin_amdgcn_mfma_f32_16x16x32_bf16(Bt[n][k], At[m][k], acc[ai][bj][m][n], 0, 0, 0); __builtin_amdgcn_s_setprio(0); } while (0)
#define PG8_WAIT_V(n) asm volatile("s_waitcnt vmcnt(" #n ")" ::: "memory")
#define PG8_WAIT_L(n) asm volatile("s_waitcnt lgkmcnt(" #n ")" ::: "memory")
#define PG8_BAR __builtin_amdgcn_s_barrier()
#define PG8_SCHED __builtin_amdgcn_sched_barrier(0)
    Unit cur, nxt; int ui = 0;
    if (!S.next(0, cur)) return;
    typename Epi::Pre pre;
    f32x4 acc[2][2][4][2];
#pragma unroll
    for (int a = 0; a < 2; ++a)
#pragma unroll
        for (int b = 0; b < 2; ++b)
#pragma unroll
            for (int m = 0; m < 4; ++m)
#pragma unroll
                for (int n = 0; n < 2; ++n) acc[a][b][m][n] = (f32x4){0.f, 0.f, 0.f, 0.f};
    bf16x8 At[4][2], B0[2][2], B1[2][2];
    const char* cA = (const char*)(cur.src ? g.A1 : g.A0) + (size_t)cur.pm * tstepA; const char* cB = (const char*)(cur.src ? g.B1 : g.B0) + (size_t)cur.pn * tstepB;
    PG8_STAGE(PG8_SB(0, 0), cB, voffB); PG8_STAGE(PG8_SB(0, 1), cB + hstepB, voffB); PG8_STAGE(PG8_SA(0, 0), cA, voffA); PG8_STAGE(PG8_SA(0, 1), cA + hstepA, voffA);
    if (wr == 1) PG8_BAR;
    PG8_WAIT_V(2); PG8_BAR;
    PG8_STAGE(PG8_SB(1, 0), cB + kstep, voffB); PG8_STAGE(PG8_SA(1, 0), cA + kstep, voffA); PG8_STAGE(PG8_SB(1, 1), cB + hstepB + kstep, voffB);
    PG8_WAIT_V(6); PG8_BAR;
    for (;;) {
        const bool has_next = S.next(ui + 1, nxt);
        E.pre(pre, cur, wr, fr);
        const char* nA = has_next ? (const char*)(nxt.src ? g.A1 : g.A0) + (size_t)nxt.pm * tstepA : cA; const char* nB = has_next ? (const char*)(nxt.src ? g.B1 : g.B0) + (size_t)nxt.pn * tstepB : cB;
        for (int t = 0; t < nt; t += 2) {
            const bool last = (t == nt - 2);
            const char* a1 = cA + (size_t)(t + 1) * kstep;
            const char* a2 = last ? nA : cA + (size_t)(t + 2) * kstep; const char* b2 = last ? nB : cB + (size_t)(t + 2) * kstep;
            const char* a3 = a2 + kstep; const char* b3 = b2 + kstep;
            PG8_LDB(B0, 0, 0); PG8_LDB(B1, 0, 1); PG8_SCHED; PG8_LDA(At, 0, 0); PG8_STAGE(PG8_SA(1, 1), a1 + hstepA, voffA);
            PG8_WAIT_V(8); PG8_WAIT_L(0); PG8_BAR; PG8_MMA(0, 0, At, B0); PG8_MMA(0, 1, At, B1); PG8_BAR; PG8_SCHED;
            PG8_LDA(At, 0, 1); PG8_STAGE(PG8_SB(0, 0), b2, voffB); PG8_STAGE(PG8_SB(0, 1), b2 + hstepB, voffB); PG8_STAGE(PG8_SA(0, 0), a2, voffA);
            PG8_WAIT_V(8); PG8_WAIT_L(0); PG8_BAR; PG8_MMA(1, 0, At, B0); PG8_MMA(1, 1, At, B1); PG8_BAR; PG8_SCHED;
            PG8_LDB(B0, 1, 0); PG8_LDB(B1, 1, 1); PG8_SCHED; PG8_LDA(At, 1, 0); PG8_STAGE(PG8_SA(0, 1), a2 + hstepA, voffA);
            PG8_WAIT_V(8); PG8_WAIT_L(0); PG8_BAR; PG8_MMA(0, 0, At, B0); PG8_MMA(0, 1, At, B1); PG8_BAR; PG8_SCHED;
            PG8_LDA(At, 1, 1); PG8_STAGE(PG8_SB(1, 0), b3, voffB); PG8_STAGE(PG8_SB(1, 1), b3 + hstepB, voffB); PG8_STAGE(PG8_SA(1, 0), a3, voffA);
            PG8_WAIT_V(8); PG8_WAIT_L(0); PG8_BAR; PG8_MMA(1, 0, At, B0); PG8_MMA(1, 1, At, B1); PG8_BAR; PG8_SCHED;
        }
        if (wr == 0) PG8_BAR;
        E(acc, cur, wr, wc, fr, fq, pre);
        if (!has_next) break;
        if (!(Epi::CHAIN && cur.src == 0)) {
#pragma unroll
            for (int a = 0; a < 2; ++a)
#pragma unroll
                for (int b = 0; b < 2; ++b)
#pragma unroll
                    for (int m = 0; m < 4; ++m)
#pragma unroll
                        for (int n = 0; n < 2; ++n) acc[a][b][m][n] = (f32x4){0.f, 0.f, 0.f, 0.f};
        }
        cur = nxt; cA = nA; cB = nB; ++ui;
        if (wr == 1) PG8_BAR;
    }
    PG8_WAIT_V(0);
    PG8_BAR;
#undef PG8_SA
#undef PG8_SB
#undef PG8_STAGE
#undef PG8_LDA
#undef PG8_LDB
#undef PG8_MMA
#undef PG8_WAIT_V
#undef PG8_WAIT_L
#undef PG8_BAR
#undef PG8_SCHED
}
}

typedef f32x4 Acc[2][2][4][2];

struct PreNone { };
struct PreRows { float v[8]; };
DI void load_rows(PreRows& pr, const float* ssq, const pg8::Unit& u, int wr, int fr) {
#pragma unroll
    for (int ai = 0; ai < 2; ++ai)
#pragma unroll
        for (int m = 0; m < 4; ++m) pr.v[ai * 4 + m] = ssq[u.pm * 256 + ai * 128 + wr * 64 + m * 16 + fr];
}
DI float msq_of(float ssq) { return ssq * (1.0f / DM) + NORM_EPS; }
DI void store8(bf16_t* p, const f32x4 v0, const f32x4 v1) {
    u32x4 w; w.x = pk2(v0[0], v0[1]); w.y = pk2(v0[2], v0[3]); w.z = pk2(v1[0], v1[1]); w.w = pk2(v1[2], v1[3]);
    *(u32x4*)p = w;
}

struct EpiGateUp {
    static constexpr bool PERM = true, CHAIN = false;
    typedef PreRows Pre;
    bf16_t* H; const float* ssq;
    DI void pre(Pre& pr, const pg8::Unit& u, int wr, int fr) const { load_rows(pr, ssq, u, wr, fr); }
    DI void operator()(Acc& acc, const pg8::Unit& u, int wr, int wc, int fr, int fq, const Pre& pr) const {
        const int col = u.pn * 128 + wc * 32 + fq * 8;
#pragma unroll
        for (int ai = 0; ai < 2; ++ai)
#pragma unroll
            for (int m = 0; m < 4; ++m) {
                const int row = u.pm * 256 + ai * 128 + wr * 64 + m * 16 + fr;
                const float msq = msq_of(pr.v[ai * 4 + m]), nrl = -1.4426950408889634f * __builtin_amdgcn_rsqf(msq);
                f32x4 h[2];
#pragma unroll
                for (int n = 0; n < 2; ++n)
#pragma unroll
                    for (int i = 0; i < 4; ++i) { const float ga = acc[ai][0][m][n][i], ua = acc[ai][1][m][n][i];
                        const float e = fast_exp2(ga * nrl); h[n][i] = (ga * ua) * fast_rcp(__builtin_fmaf(e, msq, msq)); }
                store8(H + (size_t)row * FF + col, h[0], h[1]);
            }
    }
};

template <bool RES_BF16, bool WRITE_F32, bool WRITE_XB> struct EpiResid {
    static constexpr bool PERM = true, CHAIN = false;
    typedef PreNone Pre;
    const float* res; float* out; bf16_t* xb; float* ssq; float coef;
    DI void pre(Pre&, const pg8::Unit&, int, int) const {}
    DI void operator()(Acc& acc, const pg8::Unit& u, int wr, int wc, int fr, int fq, const Pre&) const {
        const int col = u.pn * 256 + wc * 32 + fq * 8;
#pragma unroll
        for (int ai = 0; ai < 2; ++ai)
#pragma unroll
            for (int m = 0; m < 4; ++m) {
                const int row = u.pm * 256 + ai * 128 + wr * 64 + m * 16 + fr;
                float ss = 0.f;
#pragma unroll
                for (int bj = 0; bj < 2; ++bj) {
                    const size_t off = (size_t)row * DM + col + bj * 128;
                    f32x4 r0, r1;
                    if (RES_BF16) { const u32x4 rb = *(const u32x4*)(xb + off); r0 = (f32x4){bf_lo(rb.x), bf_hi(rb.x), bf_lo(rb.y), bf_hi(rb.y)}; r1 = (f32x4){bf_lo(rb.z), bf_hi(rb.z), bf_lo(rb.w), bf_hi(rb.w)}; }
                    else { r0 = *(const f32x4*)(res + off); r1 = *(const f32x4*)(res + off + 4); }
                    const f32x4 v0 = r0 + acc[ai][bj][m][0] * coef, v1 = r1 + acc[ai][bj][m][1] * coef;
                    if (WRITE_F32) { *(f32x4*)(out + off) = v0; *(f32x4*)(out + off + 4) = v1; }
                    if (WRITE_XB) { store8(xb + off, v0, v1);
                        ss += (v0[0] * v0[0] + v0[1] * v0[1]) + (v0[2] * v0[2] + v0[3] * v0[3]) + (v1[0] * v1[0] + v1[1] * v1[1]) + (v1[2] * v1[2] + v1[3] * v1[3]); }
                }
                if (WRITE_XB) { ss += __shfl_xor(ss, 16); ss += __shfl_xor(ss, 32); if (fq == 0) __hip_atomic_fetch_add(ssq + row, ss, __ATOMIC_RELAXED, __HIP_MEMORY_SCOPE_AGENT); }
            }
    }
};

struct EpiWin {
    static constexpr bool PERM = true, CHAIN = false;
    typedef PreRows Pre;
    const float* ssq; const float* rope; const float* qng; const float* kng;
    bf16_t* Q; bf16_t* KV; bf16_t* PCU; bf16_t* GB; bf16_t* MG; float* NG;
    DI void pre(Pre& pr, const pg8::Unit& u, int wr, int fr) const { load_rows(pr, ssq, u, wr, fr); }
    DI void operator()(Acc& acc, const pg8::Unit& u, int wr, int wc, int fr, int fq, const Pre& pr) const {
        const int pn = u.pn;
        if (pn < 5) {
            int do_norm, slot = 0, gidx = 0; const float* gain; float scale = 1.f;
            if (pn < 2) { do_norm = 1; gain = qng; scale = QSCALE; }
            else { const int idx = 4 * (pn - 2) + wc; slot = idx >> 1; gidx = idx & 1; do_norm = (slot == 2 || slot == 4) ? 1 : 0; gain = kng + (slot == 2 ? 64 : 128); }
            f32x4 gn[2][2];
#pragma unroll
            for (int bj = 0; bj < 2; ++bj)
#pragma unroll
                for (int n = 0; n < 2; ++n) gn[bj][n] = do_norm ? *(const f32x4*)(gain + 32 * bj + 8 * fq + 4 * n) : (f32x4){1.f, 1.f, 1.f, 1.f};
#pragma unroll
            for (int ai = 0; ai < 2; ++ai)
#pragma unroll
                for (int m = 0; m < 4; ++m) {
                    const int row = u.pm * 256 + ai * 128 + wr * 64 + m * 16 + fr;
                    const float rs = __builtin_amdgcn_rsqf(msq_of(pr.v[ai * 4 + m]));
                    f32x4 v[2][2];
#pragma unroll
                    for (int bj = 0; bj < 2; ++bj)
#pragma unroll
                        for (int n = 0; n < 2; ++n) v[bj][n] = acc[ai][bj][m][n] * rs;
                    if (do_norm) {
                        float ss = 0.f;
#pragma unroll
                        for (int bj = 0; bj < 2; ++bj)
#pragma unroll
                            for (int n = 0; n < 2; ++n) ss += (v[bj][n][0] * v[bj][n][0] + v[bj][n][1] * v[bj][n][1]) + (v[bj][n][2] * v[bj][n][2] + v[bj][n][3] * v[bj][n][3]);
                        ss += __shfl_xor(ss, 16); ss += __shfl_xor(ss, 32);
                        const float hr = __builtin_amdgcn_rsqf(ss * (1.0f / 64.0f) + NORM_EPS);
#pragma unroll
                        for (int bj = 0; bj < 2; ++bj)
#pragma unroll
                            for (int n = 0; n < 2; ++n) v[bj][n] = v[bj][n] * hr * gn[bj][n];
                        const int s = row & (SEQ - 1);
#pragma unroll
                        for (int n = 0; n < 2; ++n) {
                            f32x4 pr;
#pragma unroll
                            for (int i = 0; i < 4; ++i) pr[i] = __shfl_xor(v[0][n][i], 16);
                            if (fq < 2) {
                                const f32x4 cs = *(const f32x4*)(rope + s * 16 + 4 * n), sn = *(const f32x4*)(rope + s * 16 + 8 + 4 * n);
                                v[0][n] = (fq == 0) ? (v[0][n] * cs - pr * sn) : (v[0][n] * cs + pr * sn);
                            }
                        }
                    }
                    bf16_t* dst;
                    if (pn < 2) dst = Q + (size_t)row * 512 + (4 * pn + wc) * 64 + 8 * fq;
                    else { const int b = row >> 11, sq = row & (SEQ - 1); dst = KV + (size_t)slot * KV_SLOT + ((size_t)((b * 2 + gidx) * SEQ + sq)) * 64 + 8 * fq; }
#pragma unroll
                    for (int bj = 0; bj < 2; ++bj) store8(dst + 32 * bj, v[bj][0] * scale, v[bj][1] * scale);
                }
        } else if (pn < 9) {
            const int col = (pn - 5) * 128 + wc * 32 + fq * 8;
#pragma unroll
            for (int ai = 0; ai < 2; ++ai)
#pragma unroll
                for (int m = 0; m < 4; ++m) {
                    const int row = u.pm * 256 + ai * 128 + wr * 64 + m * 16 + fr;
                    const float rs = __builtin_amdgcn_rsqf(msq_of(pr.v[ai * 4 + m])), rs2 = rs * rs;
                    store8(PCU + (size_t)row * 512 + col, acc[ai][0][m][0] * acc[ai][1][m][0] * rs2, acc[ai][0][m][1] * acc[ai][1][m][1] * rs2);
                }
        } else if (pn < 11) {
            const int col = (pn - 9) * 256 + wc * 32 + fq * 8;
#pragma unroll
            for (int ai = 0; ai < 2; ++ai)
#pragma unroll
                for (int m = 0; m < 4; ++m) {
                    const int row = u.pm * 256 + ai * 128 + wr * 64 + m * 16 + fr;
                    const float rs = __builtin_amdgcn_rsqf(msq_of(pr.v[ai * 4 + m]));
#pragma unroll
                    for (int bj = 0; bj < 2; ++bj) store8(GB + (size_t)row * 512 + col + bj * 128, acc[ai][bj][m][0] * rs, acc[ai][bj][m][1] * rs);
                }
        } else if (pn < 19) {
            const int col = (pn - 11) * 128 + wc * 32 + fq * 8;
#pragma unroll
            for (int ai = 0; ai < 2; ++ai)
#pragma unroll
                for (int m = 0; m < 4; ++m) {
                    const int row = u.pm * 256 + ai * 128 + wr * 64 + m * 16 + fr;
                    const float nrl = -1.4426950408889634f * __builtin_amdgcn_rsqf(msq_of(pr.v[ai * 4 + m]));
                    f32x4 rr[2], gc[2];
#pragma unroll
                    for (int n = 0; n < 2; ++n)
#pragma unroll
                        for (int i = 0; i < 4; ++i) {
                            const float da = 1.0f + fast_exp2(acc[ai][0][m][n][i] * nrl), dc = 1.0f + fminf(fast_exp2(acc[ai][1][m][n][i] * nrl), 1e18f);
                            rr[n][i] = dc * fast_rcp(da); gc[n][i] = fast_rcp(dc);
                        }
                    store8(MG + (size_t)row * 2048 + col, rr[0], rr[1]);
                    store8(MG + (size_t)row * 2048 + 1024 + col, gc[0], gc[1]);
                }
        } else {
            if (wc == 0 && fq < 3) {
#pragma unroll
                for (int ai = 0; ai < 2; ++ai)
#pragma unroll
                    for (int m = 0; m < 4; ++m) {
                        const int row = u.pm * 256 + ai * 128 + wr * 64 + m * 16 + fr;
                        const float rs = __builtin_amdgcn_rsqf(msq_of(pr.v[ai * 4 + m]));
                        f32x4 s0, s1;
#pragma unroll
                        for (int i = 0; i < 4; ++i) { s0[i] = sigmoidf_(acc[ai][0][m][0][i] * rs); s1[i] = sigmoidf_(acc[ai][0][m][1][i] * rs); }
                        *(f32x4*)(NG + (size_t)row * 24 + 8 * fq) = s0; *(f32x4*)(NG + (size_t)row * 24 + 8 * fq + 4) = s1;
                    }
            }
        }
    }
};

struct EpiMerge {
    static constexpr bool PERM = true, CHAIN = true;
    typedef PreNone Pre;
    const bf16_t* MG; bf16_t* OUT;
    DI void pre(Pre&, const pg8::Unit&, int, int) const {}
    DI void operator()(Acc& acc, const pg8::Unit& u, int wr, int wc, int fr, int fq, const Pre&) const {
        const int col = u.pn * 256 + wc * 32 + fq * 8;
#pragma unroll
        for (int ai = 0; ai < 2; ++ai)
#pragma unroll
            for (int m = 0; m < 4; ++m) {
                const int row = u.pm * 256 + ai * 128 + wr * 64 + m * 16 + fr;
#pragma unroll
                for (int bj = 0; bj < 2; ++bj) {
                    const u32x4 gq = *(const u32x4*)(MG + (size_t)row * 2048 + (u.src ? 1024 : 0) + col + bj * 128);
                    const float c[8] = {bf_lo(gq.x), bf_hi(gq.x), bf_lo(gq.y), bf_hi(gq.y), bf_lo(gq.z), bf_hi(gq.z), bf_lo(gq.w), bf_hi(gq.w)};
                    if (u.src == 0) {
#pragma unroll
                        for (int e = 0; e < 8; ++e) acc[ai][bj][m][e >> 2][e & 3] *= c[e];
                    } else {
                        f32x4 v0, v1;
#pragma unroll
                        for (int i = 0; i < 4; ++i) { v0[i] = acc[ai][bj][m][0][i] * c[i]; v1[i] = acc[ai][bj][m][1][i] * c[4 + i]; }
                        store8(OUT + (size_t)row * DM + col + bj * 128, v0, v1);
                    }
                }
            }
    }
};

struct EpiCmp1 {
    static constexpr bool PERM = true, CHAIN = false;
    typedef PreNone Pre;
    const float* bias1; bf16_t* HC;
    DI void pre(Pre&, const pg8::Unit&, int, int) const {}
    DI void operator()(Acc& acc, const pg8::Unit& u, int wr, int wc, int fr, int fq, const Pre&) const {
        const int col = wc * 32 + fq * 8;
        bf16_t* base = HC + (size_t)u.src * 8192 * 256;
#pragma unroll
        for (int bj = 0; bj < 2; ++bj) {
            const f32x4 b0 = *(const f32x4*)(bias1 + u.src * 256 + col + bj * 128), b1 = *(const f32x4*)(bias1 + u.src * 256 + col + bj * 128 + 4);
#pragma unroll
            for (int ai = 0; ai < 2; ++ai)
#pragma unroll
                for (int m = 0; m < 4; ++m) {
                    const int row = u.pm * 256 + ai * 128 + wr * 64 + m * 16 + fr;
                    f32x4 v0 = acc[ai][bj][m][0] + b0, v1 = acc[ai][bj][m][1] + b1;
#pragma unroll
                    for (int i = 0; i < 4; ++i) { v0[i] = siluf_(v0[i]); v1[i] = siluf_(v1[i]); }
                    store8(base + (size_t)row * 256 + col + bj * 128, v0, v1);
                }
        }
    }
};

struct Args { const float* in[23]; float* out; unsigned char* ws; int ph_lo, ph_hi; };

enum { I_X = 0, I_F1G, I_F1WG, I_F1WU, I_F1WD, I_MIXG, I_WIN, I_QNG, I_KNG, I_PEK, I_PEV, I_CK1, I_CK2, I_CV1, I_CV2, I_CONVW, I_WA, I_WC, I_WOUT, I_F2G, I_F2WG, I_F2WU, I_F2WD };

DI void transpose_item(const float* src, int Nsrc, int nvalid, const float* gk, bf16_t* WT, int K, int n0, int k0, LAS float* scr, int lane) {
    {
        const int cc = lane & 7, kr = lane >> 3;
        f32x4 v[8];
#pragma unroll
        for (int i = 0; i < 8; ++i) { const int kk = 8 * i + kr;
            v[i] = (4 * cc < nvalid) ? *(const f32x4*)(src + (size_t)(k0 + kk) * Nsrc + 4 * cc) : (f32x4){0.f, 0.f, 0.f, 0.f}; }
        if (gk) {
#pragma unroll
            for (int i = 0; i < 8; ++i) v[i] = v[i] * gk[k0 + 8 * i + kr];
        }
#pragma unroll
        for (int i = 0; i < 8; ++i) { LAS float* d = scr + (8 * i + kr) * 33 + 4 * cc; d[0] = v[i][0]; d[1] = v[i][1]; d[2] = v[i][2]; d[3] = v[i][3]; }
    }
    asm volatile("s_waitcnt lgkmcnt(0)" ::: "memory");
    const int c = lane & 7;
#pragma unroll
    for (int j = 0; j < 4; ++j) { const int n = (lane >> 3) + 8 * j; const LAS float* s = scr + (8 * c) * 33 + n;
        u32x4 o; o.x = pk2(s[0 * 33], s[1 * 33]); o.y = pk2(s[2 * 33], s[3 * 33]); o.z = pk2(s[4 * 33], s[5 * 33]); o.w = pk2(s[6 * 33], s[7 * 33]);
        *(u32x4*)(WT + (size_t)(n0 + n) * K + k0 + 8 * c) = o; }
    asm volatile("s_waitcnt lgkmcnt(0)" ::: "memory");
}

DI void prologue_weights(const Args& a, LAS float* scr, int gw, int ngw, int lane) {
    unsigned char* ws = a.ws;
    constexpr int IT_GU = 16 * 176, IT_D = 44 * 32, IT_WIN = 16 * 160, IT_AC = 8 * 32, IT_OUT = 16 * 32, IT_CK = 32 * 8;
    constexpr int NITEMS = 2 * IT_GU + 2 * IT_D + IT_WIN + 2 * IT_AC + IT_OUT + 2 * IT_CK;
    for (int it = gw; it < NITEMS; it += ngw) {
        int r = it;
        if (r < 2 * IT_GU) {
            const int f = r / IT_GU; r -= f * IT_GU; const int nb = r % 176, kb = r / 176, n0 = nb * 32, pn = n0 >> 8, p = n0 & 255;
            const float* W = (p < 128) ? a.in[f ? I_F2WG : I_F1WG] : a.in[f ? I_F2WU : I_F1WU];
            transpose_item(W + pn * 128 + (p & 127), FF, 32, a.in[f ? I_F2G : I_F1G], (bf16_t*)(ws + (f ? WS_WGU2 : WS_WGU1)), DM, n0, kb * 64, scr, lane);
            continue;
        }
        r -= 2 * IT_GU;
        if (r < 2 * IT_D) {
            const int f = r / IT_D; r -= f * IT_D; const int nb = r % 32, kb = r / 32;
            transpose_item(a.in[f ? I_F2WD : I_F1WD] + nb * 32, DM, 32, nullptr, (bf16_t*)(ws + (f ? WS_WD2 : WS_WD1)), FF, nb * 32, kb * 64, scr, lane);
            continue;
        }
        r -= 2 * IT_D;
        if (r < IT_WIN) {
            const int nb = r % 160, kb = r / 160, n0 = nb * 32, pn = n0 >> 8, p = n0 & 255, bj = p >> 7, wc = (p & 127) >> 5;
            int sc, nv = 32;
            if (pn < 2) sc = (4 * pn + wc) * 64 + 32 * bj;
            else if (pn < 5) sc = 512 + (4 * (pn - 2) + wc) * 64 + 32 * bj;
            else if (pn < 9) sc = 1304 + 512 + bj * 512 + (pn - 5) * 128 + wc * 32;
            else if (pn < 11) sc = 1304 + (pn - 9) * 256 + p;
            else if (pn < 19) sc = 2840 + bj * 1024 + (pn - 11) * 128 + wc * 32;
            else { sc = 1280; nv = (p == 0) ? 24 : 0; }
            transpose_item(a.in[I_WIN] + sc, 4888, nv, a.in[I_MIXG], (bf16_t*)(ws + WS_WIN), DM, n0, kb * 64, scr, lane);
            continue;
        }
        r -= IT_WIN;
        if (r < 2 * IT_AC) {
            const int f = r / IT_AC; r -= f * IT_AC; const int nb = r % 32, kb = r / 32;
            transpose_item(a.in[f ? I_WC : I_WA] + nb * 32, DM, 32, nullptr, (bf16_t*)(ws + (f ? WS_WC : WS_WA)), 512, nb * 32, kb * 64, scr, lane);
            continue;
        }
        r -= 2 * IT_AC;
        if (r < IT_OUT) {
            const int nb = r % 32, kb = r / 32;
            transpose_item(a.in[I_WOUT] + nb * 32, DM, 32, nullptr, (bf16_t*)(ws + WS_WOUT), DM, nb * 32, kb * 64, scr, lane);
            continue;
        }
        r -= IT_OUT;
        {
            const int f = r / IT_CK; r -= f * IT_CK; const int nb = r % 8, kb = r / 8;
            transpose_item(a.in[f ? I_CV1 : I_CK1] + nb * 32, 256, 32, nullptr, (bf16_t*)(ws + (f ? WS_WCV1 : WS_WCK1)), 2048, nb * 32, kb * 64, scr, lane);
        }
    }
}

DI void sincos_d(double x, float& s, float& c) {
    const double k = __builtin_rint(x * 0.63661977236758134308);
    double r = x - k * 1.5707963267948966192; r -= k * 6.123233995736766036e-17;
    const double r2 = r * r;
    const double sp = r * (1.0 + r2 * (-1.0 / 6 + r2 * (1.0 / 120 + r2 * (-1.0 / 5040 + r2 * (1.0 / 362880 + r2 * (-1.0 / 39916800 + r2 * (1.0 / 6227020800.0)))))));
    const double cp = 1.0 + r2 * (-0.5 + r2 * (1.0 / 24 + r2 * (-1.0 / 720 + r2 * (1.0 / 40320 + r2 * (-1.0 / 3628800 + r2 * (1.0 / 479001600.0 + r2 * (-1.0 / 87178291200.0)))))));
    const int q = ((int)k) & 3;
    const double ss = (q == 0) ? sp : (q == 1) ? cp : (q == 2) ? -sp : -cp;
    const double cc = (q == 0) ? cp : (q == 1) ? -sp : (q == 2) ? -cp : sp;
    s = (float)ss; c = (float)cc;
}

DI void phase_prologue(const Args& a, LAS unsigned char* lds, int vcu, int G) {
    const int tid = threadIdx.x, lane = tid & 63, wave = tid >> 6;
    const int gw = vcu * 8 + wave, ngw = G * 8;
    unsigned char* ws = a.ws;
    for (int wv = gw; wv < 256 + 512; wv += ngw) {
        if (wv < 256) {
            float* rope = (float*)(ws + WS_ROPE);
            const int e = wv * 64 + lane, s = e >> 3, j = e & 7;
            float f = 1.0f;
            f = (j == 1) ? 0.1939227432012558f : f; f = (j == 2) ? 0.03760603070259094f : f; f = (j == 3) ? 0.007292664609849453f : f; f = (j == 4) ? 0.0014142135623842478f : f;
            f = (j == 5) ? 0.00027424818836152554f : f; f = (j == 6) ? 5.3182957344688475e-05f : f; f = (j == 7) ? 1.0313385246263351e-05f : f;
            const float ang = (float)s * f; float sn, cs; sincos_d((double)ang, sn, cs);
            rope[s * 16 + j] = cs; rope[s * 16 + 8 + j] = sn;
        } else {
            const int o = wv - 256, src = o >> 8, n = o & 255; const float* pe = a.in[src ? I_PEV : I_PEK]; const float* w1 = a.in[src ? I_CV1 : I_CK1];
            float acc = 0.f;
#pragma unroll 8
            for (int i = 0; i < 32; ++i) { const int k = i * 64 + lane; acc += pe[k] * w1[(size_t)k * 256 + n]; }
            acc = wave_sum(acc);
            if (lane == 0) ((float*)(ws + WS_BIAS1))[o] = acc;
        }
    }
    prologue_weights(a, (LAS float*)(lds + wave * 16384), gw, ngw, lane);
    const float* x = a.in[I_X]; bf16_t* xb = (bf16_t*)(ws + WS_XB); float* ssqA = (float*)(ws + WS_SSP);
    for (int m = gw; m < MTOK; m += 4 * ngw) {
        f32x4 v[4][4]; float sq[4];
#pragma unroll
        for (int r = 0; r < 4; ++r) { const int mr = m + r * ngw; const f32x4* xr = (const f32x4*)(x + (size_t)(mr < MTOK ? mr : m) * DM) + lane;
#pragma unroll
            for (int j = 0; j < 4; ++j) v[r][j] = xr[64 * j]; }
#pragma unroll
        for (int r = 0; r < 4; ++r) { float s = 0.f;
#pragma unroll
            for (int j = 0; j < 4; ++j) s += (v[r][j][0] * v[r][j][0] + v[r][j][1] * v[r][j][1]) + (v[r][j][2] * v[r][j][2] + v[r][j][3] * v[r][j][3]);
            sq[r] = wave_sum(s); }
#pragma unroll
        for (int r = 0; r < 4; ++r) { const int mr = m + r * ngw;
            if (mr < MTOK) {
                u32x2* o8 = (u32x2*)(xb + (size_t)mr * DM) + lane;
#pragma unroll
                for (int j = 0; j < 4; ++j) { u32x2 w; w.x = pk2(v[r][j][0], v[r][j][1]); w.y = pk2(v[r][j][2], v[r][j][3]); o8[64 * j] = w; }
                if (lane < 3) ssqA[(size_t)lane * MTOK + mr] = (lane == 0) ? sq[r] : 0.f;
            } }
    }
}

DI void conv_pass(const Args& a, int gw, int ngw, int lane) {
    const bf16_t* P = (const bf16_t*)(a.ws + WS_PCU); bf16_t* GB = (bf16_t*)(a.ws + WS_GB);
    const float* cw = a.in[I_CONVW];
    float w0[8], w1[8], w2[8];
#pragma unroll
    for (int e = 0; e < 8; ++e) { w0[e] = cw[8 * lane + e]; w1[e] = cw[512 + 8 * lane + e]; w2[e] = cw[1024 + 8 * lane + e]; }
    for (int run = gw; run < MTOK / 16; run += ngw) {
        const int t0 = run * 16; const bool first = (t0 & (SEQ - 1)) == 0;
        float p2[8], p1[8];
        { u32x4 z = {0u, 0u, 0u, 0u}; u32x4 r2 = z, r1 = z;
          if (!first) { r2 = *(const u32x4*)(P + (size_t)(t0 - 2) * 512 + 8 * lane); r1 = *(const u32x4*)(P + (size_t)(t0 - 1) * 512 + 8 * lane); }
          p2[0] = bf_lo(r2.x); p2[1] = bf_hi(r2.x); p2[2] = bf_lo(r2.y); p2[3] = bf_hi(r2.y); p2[4] = bf_lo(r2.z); p2[5] = bf_hi(r2.z); p2[6] = bf_lo(r2.w); p2[7] = bf_hi(r2.w);
          p1[0] = bf_lo(r1.x); p1[1] = bf_hi(r1.x); p1[2] = bf_lo(r1.y); p1[3] = bf_hi(r1.y); p1[4] = bf_lo(r1.z); p1[5] = bf_hi(r1.z); p1[6] = bf_lo(r1.w); p1[7] = bf_hi(r1.w); }
#pragma unroll 4
        for (int i = 0; i < 16; ++i) {
            const size_t off = (size_t)(t0 + i) * 512 + 8 * lane;
            const u32x4 r0 = *(const u32x4*)(P + off), gb = *(const u32x4*)(GB + off);
            const float p0[8] = {bf_lo(r0.x), bf_hi(r0.x), bf_lo(r0.y), bf_hi(r0.y), bf_lo(r0.z), bf_hi(r0.z), bf_lo(r0.w), bf_hi(r0.w)};
            const float g[8] = {bf_lo(gb.x), bf_hi(gb.x), bf_lo(gb.y), bf_hi(gb.y), bf_lo(gb.z), bf_hi(gb.z), bf_lo(gb.w), bf_hi(gb.w)};
            float c[8];
#pragma unroll
            for (int e = 0; e < 8; ++e) { c[e] = g[e] * (w0[e] * p2[e] + w1[e] * p1[e] + w2[e] * p0[e]); p2[e] = p1[e]; p1[e] = p0[e]; }
            u32x4 o; o.x = pk2(c[0], c[1]); o.y = pk2(c[2], c[3]); o.z = pk2(c[4], c[5]); o.w = pk2(c[6], c[7]);
            *(u32x4*)(GB + off) = o;
        }
    }
}

DI void cmp2_pass(const Args& a, LAS unsigned char* lds, int vcu, int G) {
    const int tid = threadIdx.x, lane = tid & 63, wave = tid >> 6;
    const bf16_t* HC = (const bf16_t*)(a.ws + WS_HC);
    const float kg = a.in[I_KNG][lane];
    LAS float* w2s = (LAS float*)lds;
    for (int unit = vcu; unit < 256; unit += G) {
        const int src = unit >> 7, r0 = (unit & 127) * 64 + wave * 8;
        const float* w2 = a.in[src ? I_CV2 : I_CK2];
        __syncthreads();
#pragma unroll
        for (int i = 0; i < 8; ++i) *(LAS f32x4*)(w2s + (i * 512 + tid) * 4) = *(const f32x4*)(w2 + (i * 512 + tid) * 4);
        __syncthreads();
#pragma unroll 1
        for (int g4 = 0; g4 < 2; ++g4) {
            const int rb = r0 + 4 * g4;
            const bf16_t* h = HC + (size_t)src * 8192 * 256 + (size_t)rb * 256;
            float acc[4] = {0.f, 0.f, 0.f, 0.f};
#pragma unroll 2
            for (int jb = 0; jb < 32; ++jb) {
                u32x4 h8[4];
#pragma unroll
                for (int r = 0; r < 4; ++r) h8[r] = *(const u32x4*)(h + r * 256 + 8 * jb);
                float wv[8];
#pragma unroll
                for (int e = 0; e < 8; ++e) wv[e] = w2s[(8 * jb + e) * 64 + lane];
#pragma unroll
                for (int r = 0; r < 4; ++r) {
                    acc[r] += bf_lo(h8[r].x) * wv[0]; acc[r] += bf_hi(h8[r].x) * wv[1]; acc[r] += bf_lo(h8[r].y) * wv[2]; acc[r] += bf_hi(h8[r].y) * wv[3];
                    acc[r] += bf_lo(h8[r].z) * wv[4]; acc[r] += bf_hi(h8[r].z) * wv[5]; acc[r] += bf_lo(h8[r].w) * wv[6]; acc[r] += bf_hi(h8[r].w) * wv[7];
                }
            }
#pragma unroll
            for (int r = 0; r < 4; ++r) {
                const int row = rb + r, n = row & 127;
                float v = acc[r];
                if (src == 0) { const float ss = wave_sum(v * v); v = v * __builtin_amdgcn_rsqf(ss * (1.0f / 64.0f) + NORM_EPS) * kg; }
                if (n == 127) v = 0.f;
                bf16_t* dst = (bf16_t*)(a.ws + (src ? WS_VCC : WS_KCC)) + (size_t)row * 64 + lane;
                *dst = (bf16_t)(pk2(v, 0.f) & 0xffffu);
            }
        }
    }
}

#define MFMA32(a, b, c) __builtin_amdgcn_mfma_f32_32x32x16_bf16((a), (b), (c), 0, 0, 0)
constexpr int VT_PITCH = 72;
constexpr int LDS_VT = 8192, ATT_BUF = 16384, LDS_IMP = 65536, LDS_VAL = 99328, LDS_MSK = 107520, LDS_LIST = 108544, LDS_GATE = 109568, LDS_SCL = 115712, LDS_STG = 65536, IMP_PITCH = 33;

DI float half_max(float v) { auto rr = __builtin_amdgcn_permlane32_swap(__float_as_uint(v), __float_as_uint(v), false, false); return fmaxf(__uint_as_float(rr[0]), __uint_as_float(rr[1])); }
DI float half_sum(float v) { auto rr = __builtin_amdgcn_permlane32_swap(__float_as_uint(v), __float_as_uint(v), false, false); return __uint_as_float(rr[0]) + __uint_as_float(rr[1]); }
typedef short s16x4 __attribute__((ext_vector_type(4)));
typedef short v4i16_t __attribute__((ext_vector_type(4)));
DI void attn_tile(LAS const unsigned char* Ks, LAS const unsigned char* VT, const bf16x8 (&qf)[4], int ql, int hi,
                  bool need_mask, bool col_en, int lo_b, int hi_b, float& m_ref, float& l_run, f32x16 (&o)[2], f32x16 (&sp)[2]) {
    const int lane_ = ql + 32 * hi;
    const float bias = col_en ? -m_ref : -INFINITY;
    const bool plain = __all(col_en && (m_ref == 0.f));
#pragma unroll
    for (int p = 0; p < 2; ++p) {
        bf16x8 kf[4];
#pragma unroll
        for (int d0 = 0; d0 < 4; ++d0) { const int c = 2 * d0 + hi; kf[d0] = *(LAS const bf16x8*)(Ks + c * 1024 + ((ql + 32 * p) << 4)); }
        f32x16 acc;
        if (plain) {
#pragma unroll
            for (int r = 0; r < 16; ++r) acc[r] = 0.f;
#pragma unroll
            for (int d0 = 0; d0 < 4; ++d0) acc = MFMA32(kf[d0], qf[d0], acc);
        } else {
#pragma unroll
            for (int r = 0; r < 16; ++r) acc[r] = bias;
#pragma unroll
            for (int d0 = 0; d0 < 4; ++d0) acc = MFMA32(kf[d0], qf[d0], acc);
        }
        sp[p] = acc;
    }
    if (need_mask) {
#pragma unroll
        for (int p = 0; p < 2; ++p)
#pragma unroll
            for (int r = 0; r < 16; ++r) { const int kvl = 32 * p + (r & 3) + 8 * (r >> 2) + 4 * hi; const bool ok = (kvl <= hi_b) && (kvl > lo_b); sp[p][r] = ok ? sp[p][r] : -INFINITY; }
    }
    float tm = fmaxf(fmaxf(sp[0][0], sp[0][1]), sp[1][0]);
#pragma unroll
    for (int r = 2; r < 16; r += 2) tm = fmaxf(fmaxf(tm, sp[0][r]), sp[0][r + 1]);
#pragma unroll
    for (int r = 1; r < 15; r += 2) tm = fmaxf(fmaxf(tm, sp[1][r]), sp[1][r + 1]);
    tm = fmaxf(tm, sp[1][15]);
    tm = half_max(tm);
    if (__any((tm > 16.f) || ((tm < -16.f) && (tm > -INFINITY)))) {
        const bool up = tm > 16.f;
        const bool dn = (tm < -16.f) && (tm > -INFINITY) && (half_sum(l_run) == 0.f);
        const float dlt = (up || dn) ? tm : 0.f;
        const float alpha = up ? fast_exp2(-dlt) : 1.0f;
        l_run *= alpha; m_ref += dlt;
#pragma unroll
        for (int r = 0; r < 16; ++r) { o[0][r] *= alpha; o[1][r] *= alpha; sp[0][r] -= dlt; sp[1][r] -= dlt; }
    }
    f32x2_t ps = {0.f, 0.f};
#pragma unroll
    for (int r = 0; r < 16; ++r) { const float e0 = fast_exp2(sp[0][r]), e1 = fast_exp2(sp[1][r]); sp[0][r] = e0; sp[1][r] = e1; ps += (f32x2_t){e0, e1}; }
    l_run += ps[0] + ps[1];
    bf16x8 pk[2][2];
#pragma unroll
    for (int p = 0; p < 2; ++p)
#pragma unroll
        for (int s = 0; s < 2; ++s) { u32x4 w; w.x = pk2(sp[p][8 * s], sp[p][8 * s + 1]); w.y = pk2(sp[p][8 * s + 2], sp[p][8 * s + 3]); w.z = pk2(sp[p][8 * s + 4], sp[p][8 * s + 5]); w.w = pk2(sp[p][8 * s + 6], sp[p][8 * s + 7]); pk[p][s] = __builtin_bit_cast(bf16x8, w); }
    LAS const unsigned char* vb = VT + ((lane_ >> 4) & 1) * 32 + (lane_ & 3) * 8 + (4 * hi + ((lane_ & 15) >> 2)) * 64;
#pragma unroll
    for (int dh = 0; dh < 2; ++dh) {
        bf16x8 vf[4];
#pragma unroll
        for (int ks = 0; ks < 4; ++ks) {
            const s16x4 lo = __builtin_bit_cast(s16x4, __builtin_amdgcn_ds_read_tr16_b64_v4i16((LAS v4i16_t*)(vb + dh * 4096 + ks * 1024)));
            const s16x4 hh = __builtin_bit_cast(s16x4, __builtin_amdgcn_ds_read_tr16_b64_v4i16((LAS v4i16_t*)(vb + dh * 4096 + ks * 1024 + 512)));
            vf[ks] = (bf16x8){lo[0], lo[1], lo[2], lo[3], hh[0], hh[1], hh[2], hh[3]};
        }
#pragma unroll
        for (int ks = 0; ks < 4; ++ks) o[dh] = MFMA32(vf[ks], pk[ks >> 1][ks & 1], o[dh]);
    }
}

DI void glds16(const void* gsrc, unsigned lds_dst) { unsigned keep;
    asm volatile("s_mov_b32 %0, m0\n\ts_mov_b32 m0, %2\n\ts_nop 0\n\tglobal_load_lds_dwordx4 %1, off\n\ts_mov_b32 m0, %0" : "=&s"(keep) : "v"(gsrc), "s"(lds_dst) : "memory"); }

DI void attn_unit(LAS unsigned char* lds, const Args& a, int bg, int qt) {
    const int tid = threadIdx.x, lane = tid & 63, w = __builtin_amdgcn_readfirstlane(tid >> 6);
    const int hl = w >> 1, qs = w & 1, ql = lane & 31, hi = lane >> 5, qloc = 32 * qs + ql;
    const int b = bg >> 1, g = bg & 1, head = g * 4 + hl;
    const size_t tok = (size_t)b * SEQ + qt * 64 + qloc;
    const bf16_t* Qb = (const bf16_t*)(a.ws + WS_Q); const bf16_t* KVb = (const bf16_t*)(a.ws + WS_KV);
    const float* NG = (const float*)(a.ws + WS_NG); bf16_t* AO = (bf16_t*)(a.ws + WS_AO);
    bf16x8 qf[4];
    { const bf16_t* qp = Qb + tok * 512 + head * 64 + hi * 8;
#pragma unroll
      for (int d0 = 0; d0 < 4; ++d0) qf[d0] = *(const bf16x8*)(qp + 16 * d0); }
    LAS float* GT = (LAS float*)(lds + LDS_GATE) + tid;
    GT[0] = NG[tok * 24 + head]; GT[512] = NG[tok * 24 + 8 + head]; GT[1024] = NG[tok * 24 + 16 + head];
    LAS float* IMP = (LAS float*)(lds + LDS_IMP); LAS float* VAL = (LAS float*)(lds + LDS_VAL);
    LAS unsigned* MSK = (LAS unsigned*)(lds + LDS_MSK); LAS int* LIST = (LAS int*)(lds + LDS_LIST);
    const unsigned lds_base = (unsigned)(uintptr_t)lds;
    const size_t kofs = (size_t)lane * 64 + w * 8;
    const size_t vofs = (size_t)(16 * (w & 3) + (lane >> 2)) * 64 + 32 * (w >> 2) + 8 * (lane & 3);
#define DMA_TILE(Kp, Vp, slot) do { \
        glds16((Kp) + kofs, (unsigned)__builtin_amdgcn_readfirstlane((int)(lds_base + (unsigned)((slot) * ATT_BUF + w * 1024)))); \
        glds16((Vp) + vofs, (unsigned)__builtin_amdgcn_readfirstlane((int)(lds_base + (unsigned)((slot) * ATT_BUF + LDS_VT + w * 1024)))); } while (0)
#define WAIT_VM(n) asm volatile("s_waitcnt vmcnt(" #n ")" ::: "memory")
#define LBAR() do { asm volatile("s_waitcnt lgkmcnt(0)" ::: "memory"); __builtin_amdgcn_s_barrier(); asm volatile("" ::: "memory"); } while (0)

    const bf16_t* KC = (const bf16_t*)(a.ws + WS_KCC) + (size_t)bg * 8192;
    const bf16_t* KS = KVb + 2 * KV_SLOT + (size_t)bg * SEQ * 64;
    constexpr size_t VC_OFF = (WS_VCC - WS_KCC) / 2;

    f32x16 oacc[2], o[2], sp[2];
#pragma unroll
    for (int r = 0; r < 16; ++r) { oacc[0][r] = 0.f; oacc[1][r] = 0.f; o[0][r] = 0.f; o[1][r] = 0.f; }
    float m_ref = 0.f, l_run = 0.f;
    const int pos = qt * 64 + qloc;

    float mu0 = 0.f, xcross = 0.f;
    LAS float* ip = IMP + (hl * 64 + qloc) * IMP_PITCH;
    const bool two_cmp = qt >= 16;
    DMA_TILE(KC, KC + VC_OFF, 0);
    if (two_cmp) DMA_TILE(KC + 4096, KC + VC_OFF + 4096, 1);
    DMA_TILE(KS, KS + KV_SLOT, 2);
    WAIT_VM(0);
    __syncthreads();
#pragma unroll
    for (int ct = 0; ct < 2; ++ct) {
        if (ct == 0 || two_cmp) {
            const int hb = ((pos - 31) >> 4) - 64 * ct;
            LAS const unsigned char* kb = lds + ct * ATT_BUF;
            attn_tile(kb, kb + LDS_VT, qf, ql, hi, true, true, -1, hb, m_ref, l_run, o, sp);
            if (ct == 0) mu0 = m_ref;
            float prev = 0.f;
            if (two_cmp)
#pragma unroll
            for (int kk = 0; kk < 8; ++kk) { const int p = kk >> 2, k = kk & 3;
                const float xk = __shfl_xor(sp[p][4 * k + 3], 32);
                const float e4 = (sp[p][4 * k] + sp[p][4 * k + 1]) + (sp[p][4 * k + 2] + sp[p][4 * k + 3]);
                ip[16 * ct + 2 * kk + hi] = e4 + (hi ? xk : prev);
                prev = xk; asm volatile("" : "+v"(prev)); }
            if (ct == 0) xcross = prev;
        }
    }
    {
        const float lt = half_sum(l_run);
        const float inv = lt > 0.f ? 1.0f / lt : 0.f;
        const float gi = GT[0] * inv;
#pragma unroll
        for (int r = 0; r < 16; ++r) { oacc[0][r] += gi * o[0][r]; oacc[1][r] += gi * o[1][r]; o[0][r] = 0.f; o[1][r] = 0.f; }
        const float f0 = fast_exp2(mu0 - m_ref) * inv;
        if (two_cmp && hi == 0) { LAS float* sc = (LAS float*)(lds + LDS_SCL) + (hl * 64 + qloc) * 3; sc[0] = f0; sc[1] = inv; sc[2] = xcross * f0; }
        m_ref = 0.f; l_run = 0.f;
    }
    __syncthreads();
    const unsigned causal_all = (qt == 31) ? 0xffffffffu : ((1u << (qt + 1)) - 1u);
    if (two_cmp) {
        const int j = tid & 31;
        LAS const float* SCL = (LAS const float*)(lds + LDS_SCL);
#pragma unroll
        for (int it = 0; it < 4; ++it) { const int q = (tid >> 5) + 16 * it;
            float v = 0.f;
#pragma unroll
            for (int h = 0; h < 4; ++h) { const int hq = h * 64 + q; const float sc = SCL[hq * 3 + (j >> 4)]; v += IMP[hq * IMP_PITCH + j] * sc + ((j == 16) ? SCL[hq * 3 + 2] : 0.f); }
            const bool forced = (j == 0) || (j == qt) || (j == qt - 1);
            v = forced ? 1e4f : (j > qt ? -1.0f : v);
            VAL[q * 32 + j] = v; }
        __syncthreads();
        const unsigned causal_bits = (qt == 31) ? 0xffffffffu : ((1u << (qt + 1)) - 1u);
#pragma unroll
        for (int it = 0; it < 4; ++it) { const int q = (tid >> 5) + 16 * it;
            const float v = VAL[q * 32 + j]; int cnt = 0;
#pragma unroll 8
            for (int jj = 0; jj < 32; ++jj) { const float ov = VAL[q * 32 + jj]; cnt += ((ov > v) || (ov == v && jj < j)) ? 1 : 0; }
            const unsigned long long bal = __ballot(cnt < 16);
            const unsigned mk = ((lane < 32) ? (unsigned)bal : (unsigned)(bal >> 32)) & causal_bits;
            if ((lane & 31) == 0) MSK[q] = mk; }
        __syncthreads();
        if (w == 0) {
            int ln = lane; asm volatile("" : "+v"(ln));
            unsigned U = MSK[ln];
#pragma unroll
            for (int of = 1; of < 64; of <<= 1) U |= (unsigned)__shfl_xor((int)U, of);
            const int n = __popc(U), j0 = qt - 8 < 0 ? 0 : qt - 8;
            if (ln < 32) { if ((U >> ln) & 1u) LIST[__popc(U & ((1u << ln) - 1u))] = ln; }
            else if (j0 + (ln - 32) <= qt) LIST[n + ln - 32] = j0 + (ln - 32);
            if (ln == 0) { LIST[64] = n; LIST[65] = n + (qt - j0 + 1); }
        }
        __syncthreads();
    } else {
        if (w == 0) {
            int ln = lane; asm volatile("" : "+v"(ln));
            const int n = qt + 1, j0 = qt - 8 < 0 ? 0 : qt - 8;
            if (ln < 32) { if (ln <= qt) LIST[ln] = ln; }
            else if (j0 + (ln - 32) <= qt) LIST[n + ln - 32] = j0 + (ln - 32);
            if (ln == 0) { LIST[64] = n; LIST[65] = n + (qt - j0 + 1); }
        }
        __syncthreads();
    }
    const unsigned mask_q = two_cmp ? MSK[qloc] : causal_all;
    const int nsel = LIST[64], ntile = LIST[65];
#define TILE_SRC(ii, kp, vp) do { const int jn_ = LIST[(ii)]; const bool ns_ = (ii) < nsel; kp = KS + (ns_ ? (size_t)0 : 2 * KV_SLOT) + (size_t)jn_ * 4096; vp = kp + KV_SLOT; } while (0)
    if (ntile > 1) { const bf16_t* kp; const bf16_t* vp; TILE_SRC(1, kp, vp); DMA_TILE(kp, vp, 3); }
    if (ntile > 2) { const bf16_t* kp; const bf16_t* vp; TILE_SRC(2, kp, vp); DMA_TILE(kp, vp, 0); }
    for (int i = 0; i < ntile; ++i) {
        const int j = LIST[i]; const bool is_sel = i < nsel;
        if (i + 2 < ntile) WAIT_VM(4); else if (i + 1 < ntile) WAIT_VM(2); else WAIT_VM(0);
        LBAR();
        if (i + 3 < ntile) { const bf16_t* kp; const bf16_t* vp; TILE_SRC(i + 3, kp, vp); DMA_TILE(kp, vp, (i + 1) & 3); }
        if (i == nsel) {
            const float lt = half_sum(l_run); const float gi = GT[512] / lt;
#pragma unroll
            for (int r = 0; r < 16; ++r) { oacc[0][r] += gi * o[0][r]; oacc[1][r] += gi * o[1][r]; o[0][r] = 0.f; o[1][r] = 0.f; }
            m_ref = 0.f; l_run = 0.f;
        }
        bool need_mask, col_en = true; int lo_b = -1, hi_b = 63;
        if (is_sel) { need_mask = (j == qt); if (j == qt) hi_b = qloc; col_en = ((mask_q >> j) & 1u) != 0u; }
        else { need_mask = (j == qt) || (j == qt - 8); if (j == qt) hi_b = qloc; if (j == qt - 8) lo_b = qloc; }
        LAS const unsigned char* kb = lds + ((i + 2) & 3) * ATT_BUF;
        attn_tile(kb, kb + LDS_VT, qf, ql, hi, need_mask, col_en, lo_b, hi_b, m_ref, l_run, o, sp);
    }
#undef TILE_SRC
    {
        const float lt = half_sum(l_run); const float gi = GT[1024] / lt;
#pragma unroll
        for (int r = 0; r < 16; ++r) { oacc[0][r] += gi * o[0][r]; oacc[1][r] += gi * o[1][r]; }
    }
    {
        LAS bf16_t* stg = (LAS bf16_t*)(lds + LDS_STG + w * 4608);
#pragma unroll
        for (int dh = 0; dh < 2; ++dh)
#pragma unroll
            for (int r = 0; r < 16; r += 2) {
                const int d = 32 * dh + (r & 3) + 8 * (r >> 2) + 4 * hi;
                *(LAS unsigned*)(stg + ql * VT_PITCH + d) = pk2(oacc[dh][r], oacc[dh][r + 1]);
            }
        asm volatile("s_waitcnt lgkmcnt(0)" ::: "memory");
        bf16_t* dst = AO + ((size_t)b * SEQ + qt * 64 + 32 * qs) * 512 + head * 64;
#pragma unroll
        for (int i2 = 0; i2 < 4; ++i2) { const int row = i2 * 8 + (lane >> 3), ch = lane & 7; const u32x4 v = *(LAS const u32x4*)(stg + row * VT_PITCH + ch * 8); *(u32x4*)(dst + (size_t)row * 512 + ch * 8) = v; }
    }
#undef DMA_TILE
#undef WAIT_VM
#undef LBAR
}


#define XB_TMO      128
#define XB_XCNT(j)  (256  + 64 * (j))
#define XB_XSUB(j)  (1280 + 64 * (j))
#define XB_XGEN(j)  (2304 + 64 * (j))
#define XB_TOP      3328
#define XB_TOPGEN   3392
#define XCD_BAR_WORDS 3456
#define XB_SPIN_CAP (1u << 20)
DI unsigned xb_ld(unsigned* p)              { return __hip_atomic_load(p, __ATOMIC_RELAXED, __HIP_MEMORY_SCOPE_AGENT); }
DI unsigned xb_add(unsigned* p, unsigned v) { return __hip_atomic_fetch_add(p, v, __ATOMIC_RELAXED, __HIP_MEMORY_SCOPE_AGENT); }
DI unsigned xb_xcc_id() { return (unsigned)__builtin_amdgcn_s_getreg((3 << 11) | 20) & 0xFu; }
#define XB_SPIN(cond, bar) do { unsigned _sp = 0; while (cond) { __builtin_amdgcn_s_sleep(1); \
    if ((++_sp & 255u) == 0u) { if (xb_ld(&(bar)[XB_TMO])) break; if (_sp > XB_SPIN_CAP) { atomicAdd(&(bar)[XB_TMO], 1u); break; } } } } while (0)
struct XcdBarrier { unsigned* bar; unsigned x; volatile LAS unsigned* st; };
DI XcdBarrier xcd_barrier_post(unsigned* bar, volatile LAS unsigned* st) {
    XcdBarrier b; b.bar = bar; b.x = xb_xcc_id(); b.st = st;
    if (threadIdx.x == 0) (void)xb_add(&bar[XB_XCNT(b.x)], 1u);
    return b;
}
DI void xcd_barrier_complete(unsigned* bar, unsigned x, unsigned& nloc, unsigned& nx) {
    const unsigned G = gridDim.x * gridDim.y * gridDim.z;
    unsigned sum, cnt, mine, sp = 0u;
    for (;;) {
        sum = 0u; cnt = 0u; mine = 0u;
#pragma unroll
        for (unsigned j = 0; j < 16; ++j) { const unsigned c = xb_ld(&bar[XB_XCNT(j)]); sum += c; cnt += (c > 0u) ? 1u : 0u; mine = (j == x) ? c : mine; }
        if (sum == G) break;
        __builtin_amdgcn_s_sleep(1);
        if ((++sp & 255u) == 0u) { if (xb_ld(&bar[XB_TMO])) break; if (sp > XB_SPIN_CAP) { atomicAdd(&bar[XB_TMO], 1u); break; } }
    }
    nloc = mine > 0u ? mine : 1u; nx = cnt > 0u ? cnt : 1u;
}
DI void xcd_barrier(const XcdBarrier& b) {
    asm volatile("s_waitcnt vmcnt(0)" ::: "memory");
    __syncthreads();
    if (threadIdx.x == 0) {
        unsigned* bar = b.bar;
        __builtin_amdgcn_s_waitcnt(0);
        unsigned nloc = b.st[0], nx = b.st[1];
        if (nloc == 0u) { xcd_barrier_complete(bar, b.x, nloc, nx); b.st[0] = nloc; b.st[1] = nx; }
        const unsigned old = xb_add(&bar[XB_XSUB(b.x)], 1u);
        const unsigned gen = old / nloc;
        if (old + 1u == (gen + 1u) * nloc) {
            __builtin_amdgcn_fence(__ATOMIC_RELEASE, "agent");
            asm volatile("s_waitcnt vmcnt(0)" ::: "memory");
            const unsigned og = xb_add(&bar[XB_TOP], 1u);
            const unsigned tg = og / nx;
            if (og + 1u == (tg + 1u) * nx) xb_add(&bar[XB_TOPGEN], 1u);
            else XB_SPIN(xb_ld(&bar[XB_TOPGEN]) == tg, bar);
            __builtin_amdgcn_fence(__ATOMIC_ACQUIRE, "agent");
            xb_add(&bar[XB_XGEN(b.x)], 1u);
            asm volatile("s_waitcnt vmcnt(0)" ::: "memory");
        } else {
            XB_SPIN(xb_ld(&bar[XB_XGEN(b.x)]) == gen, bar);
            __builtin_amdgcn_fence(__ATOMIC_ACQUIRE, "agent");
            asm volatile("s_waitcnt vmcnt(0)" ::: "memory");
        }
    }
    __syncthreads();
}

constexpr int LDS_BYTES = 147456;
constexpr int N_PHASES = 11;

__global__ void __launch_bounds__(512, 2) mk_fwd(Args args) {
    extern __shared__ __attribute__((aligned(16))) unsigned char lds_raw[];
    LAS unsigned char* lds = (LAS unsigned char*)lds_raw;
    const int G = gridDim.x, bx = blockIdx.x;
    const int vcu = (G % 8 == 0) ? (bx % 8) * (G / 8) + bx / 8 : bx;
    const int tid = threadIdx.x, lane = tid & 63, wave = tid >> 6;
    unsigned char* ws = args.ws;
    const int lo = args.ph_lo, hi = args.ph_hi;
    cg::grid_group grid = cg::this_grid();
#define IN(k) (lo <= (k) && (k) < hi)
    volatile LAS unsigned* bst = (volatile LAS unsigned*)(lds + LDS_BYTES - 64);
    if (tid == 0) { bst[0] = 0u; bst[1] = 0u; }
    __syncthreads();
    XcdBarrier xbar = xcd_barrier_post((unsigned*)ws, bst);
#define SEAM(k) do { if (IN(k) && IN((k) + 1)) { if (lo < 0) grid.sync(); else xcd_barrier(xbar); } } while (0)
    float* ssqA = (float*)(ws + WS_SSP); float* ssqB = ssqA + MTOK; float* ssqC = ssqB + MTOK; bf16_t* xb = (bf16_t*)(ws + WS_XB);

    if (IN(0)) phase_prologue(args, lds, vcu, G);
    SEAM(0);
    if (IN(1)) {
        pg8::Gemm g{xb, xb, (const bf16_t*)(ws + WS_WGU1), (const bf16_t*)(ws + WS_WGU1), DM, DM, DM};
        pg8::StaticOrder<false> S; S.init(MTOK, NGU, G, bx);
        EpiGateUp E{(bf16_t*)(ws + WS_HID), ssqA};
        pg8::gemm_phase(lds, g, S, E);
    }
    SEAM(1);
    if (IN(2)) {
        const bf16_t* H = (const bf16_t*)(ws + WS_HID);
        pg8::Gemm g{H, H, (const bf16_t*)(ws + WS_WD1), (const bf16_t*)(ws + WS_WD1), FF, FF, FF};
        pg8::StaticOrder<false> S; S.init(MTOK, DM, G, bx);
        EpiResid<true, false, true> E{nullptr, nullptr, xb, ssqB, 0.5f};
        pg8::gemm_phase(lds, g, S, E);
    }
    SEAM(2);
    if (IN(3)) {
        pg8::Gemm g{xb, xb, (const bf16_t*)(ws + WS_WIN), (const bf16_t*)(ws + WS_WIN), DM, DM, DM};
        pg8::StaticOrder<false> S; S.init(MTOK, NWIN, G, bx);
        EpiWin E{ssqB, (const float*)(ws + WS_ROPE), args.in[I_QNG], args.in[I_KNG], (bf16_t*)(ws + WS_Q), (bf16_t*)(ws + WS_KV), (bf16_t*)(ws + WS_PCU), (bf16_t*)(ws + WS_GB), (bf16_t*)(ws + WS_MG), (float*)(ws + WS_NG)};
        pg8::gemm_phase(lds, g, S, E);
    }
    SEAM(3);
    if (IN(4)) {
        if (vcu < 64) {
            const bf16_t* KVb = (const bf16_t*)(ws + WS_KV);
            pg8::Gemm g{KVb, KVb + KV_SLOT, (const bf16_t*)(ws + WS_WCK1), (const bf16_t*)(ws + WS_WCV1), 1024, 2048, 2048};
            pg8::CmpOrder S{vcu};
            EpiCmp1 E{(const float*)(ws + WS_BIAS1), (bf16_t*)(ws + WS_HC)};
            pg8::gemm_phase(lds, g, S, E);
        } else {
            const int nconv = (G > 64) ? (G - 64) : 0;
            conv_pass(args, (vcu - 64) * 8 + wave, nconv * 8, lane);
        }
    }
    SEAM(4);
    if (IN(5)) cmp2_pass(args, lds, vcu, G);
    SEAM(5);
    if (IN(6)) {
        for (int uix = vcu; uix < 2048; uix += G) {
            const int v = uix & 255, i = uix >> 8, x = v >> 5, k = v & 31, bg = x * 8 + i;
            const int f = (k + 8 * (i >> 1)) & 31, qt = (i & 1) ? 31 - f : f;
            attn_unit(lds, args, bg, qt);
            asm volatile("s_waitcnt lgkmcnt(0)" ::: "memory"); __builtin_amdgcn_s_barrier(); asm volatile("" ::: "memory");
        }
    }
    SEAM(6);
    if (IN(7)) {
        pg8::Gemm g{(const bf16_t*)(ws + WS_AO), (const bf16_t*)(ws + WS_GB), (const bf16_t*)(ws + WS_WA), (const bf16_t*)(ws + WS_WC), 512, 512, 512};
        pg8::StaticOrder<true> S; S.init(MTOK, DM, G, bx);
        EpiMerge E{(const bf16_t*)(ws + WS_MG), (bf16_t*)(ws + WS_MERGED)};
        pg8::gemm_phase(lds, g, S, E);
    }
    SEAM(7);
    if (IN(8)) {
        const bf16_t* Mg = (const bf16_t*)(ws + WS_MERGED);
        pg8::Gemm g{Mg, Mg, (const bf16_t*)(ws + WS_WOUT), (const bf16_t*)(ws + WS_WOUT), DM, DM, DM};
        pg8::StaticOrder<false> S; S.init(MTOK, DM, G, bx);
        EpiResid<true, false, true> E{nullptr, nullptr, xb, ssqC, 1.0f};
        pg8::gemm_phase(lds, g, S, E);
    }
    SEAM(8);
    if (IN(9)) {
        pg8::Gemm g{xb, xb, (const bf16_t*)(ws + WS_WGU2), (const bf16_t*)(ws + WS_WGU2), DM, DM, DM};
        pg8::StaticOrder<false> S; S.init(MTOK, NGU, G, bx);
        EpiGateUp E{(bf16_t*)(ws + WS_HID), ssqC};
        pg8::gemm_phase(lds, g, S, E);
    }
    SEAM(9);
    if (IN(10)) {
        const bf16_t* H = (const bf16_t*)(ws + WS_HID);
        pg8::Gemm g{H, H, (const bf16_t*)(ws + WS_WD2), (const bf16_t*)(ws + WS_WD2), FF, FF, FF};
        pg8::StaticOrder<false> S; S.init(MTOK, DM, G, bx);
        EpiResid<true, true, false> E{nullptr, args.out, xb, nullptr, 0.5f};
        pg8::gemm_phase(lds, g, S, E);
    }
#undef IN
#undef SEAM
}

extern "C" void kernel_launch(void* const* d_in, const int* in_sizes, int n_in, void* d_out, int out_size, void* d_ws, size_t ws_size, hipStream_t stream) {
    static int grid = 0;
    if (grid == 0) {
        if (n_in != 23 || in_sizes[0] != MTOK * DM || out_size != MTOK * DM || ws_size < WS_END) {
            fprintf(stderr, "kernel_launch: unexpected shapes (n_in %d, in0 %d, out %d, ws %zu, need %zu)\n", n_in, n_in > 0 ? in_sizes[0] : -1, out_size, ws_size, (size_t)WS_END); grid = -1; return; }
        int dev = 0, cus = 0;
        if (hipGetDevice(&dev) != hipSuccess || hipDeviceGetAttribute(&cus, hipDeviceAttributeMultiprocessorCount, dev) != hipSuccess) { grid = -1; return; }
        if (hipFuncSetAttribute((const void*)mk_fwd, hipFuncAttributeMaxDynamicSharedMemorySize, LDS_BYTES) != hipSuccess) { fprintf(stderr, "kernel_launch: hipFuncSetAttribute failed\n"); grid = -1; return; }
        int per_cu = 0;
        if (hipOccupancyMaxActiveBlocksPerMultiprocessor(&per_cu, (const void*)mk_fwd, 512, LDS_BYTES) != hipSuccess || per_cu < 1) { fprintf(stderr, "kernel_launch: occupancy query says %d\n", per_cu); (void)hipGetLastError(); }
        grid = cus;
    }
    if (grid < 0) return;
    if (hipMemsetAsync(d_ws, 0, 16384, stream) != hipSuccess) { fprintf(stderr, "kernel_launch: hipMemsetAsync of the barrier words failed\n"); return; }
    Args a{};
    for (int i = 0; i < 23; ++i) a.in[i] = (const float*)d_in[i];
    a.out = (float*)d_out; a.ws = (unsigned char*)d_ws;
#if MK_N_LAUNCHES == 1
    a.ph_lo = 0; a.ph_hi = N_PHASES;
    void* kargs[] = {&a};
    hipError_t e = hipLaunchCooperativeKernel((const void*)mk_fwd, dim3(grid), dim3(512), kargs, LDS_BYTES, stream);
    if (e != hipSuccess) fprintf(stderr, "kernel_launch: cooperative launch failed: %s (grid %d)\n", hipGetErrorString(e), grid);
#else
    for (int p = 0; p < N_PHASES; ++p) {
        a.ph_lo = p; a.ph_hi = p + 1;
        hipLaunchKernelGGL(mk_fwd, dim3(grid), dim3(512), LDS_BYTES, stream, a);
    }
#endif
}
```

```cpp
#include <hip/hip_runtime.h>
#include <hip/hip_cooperative_groups.h>
#include <cstdio>
#include <cstdint>
namespace cg = cooperative_groups;

#ifndef MK_N_LAUNCHES
#define MK_N_LAUNCHES 1
#endif

#define DI __device__ __forceinline__
#define LAS __attribute__((address_space(3)))
typedef unsigned short bf16_t;
typedef short bf16x8 __attribute__((ext_vector_type(8)));
typedef float f32x4 __attribute__((ext_vector_type(4)));
typedef float f32x16 __attribute__((ext_vector_type(16)));
typedef unsigned u32x4 __attribute__((ext_vector_type(4)));
typedef unsigned u32x2 __attribute__((ext_vector_type(2)));
typedef float f32x2_t __attribute__((ext_vector_type(2)));
typedef __bf16 bf16x2_t __attribute__((ext_vector_type(2)));

DI unsigned pk2(float lo, float hi) { f32x2_t v = {lo, hi}; bf16x2_t b = __builtin_convertvector(v, bf16x2_t); return __builtin_bit_cast(unsigned, b); }
DI float bf_lo(unsigned u) { return __uint_as_float(u << 16); }
DI float bf_hi(unsigned u) { return __uint_as_float(u & 0xffff0000u); }
DI float fast_exp2(float x) { return __builtin_amdgcn_exp2f(x); }
DI float fast_rcp(float x) { return __builtin_amdgcn_rcpf(x); }
DI float sigmoidf_(float x) { return fast_rcp(1.f + fast_exp2(-1.4426950408889634f * x)); }
DI float siluf_(float x) { return x * sigmoidf_(x); }
DI float wave_sum(float v) {
#pragma unroll
    for (int o = 1; o < 64; o <<= 1) v += __shfl_xor(v, o);
    return v;
}

constexpr int SEQ = 2048, DM = 1024, MTOK = 65536, FF = 2816, NGU = 5632, NWIN = 5120;
constexpr float NORM_EPS = 1e-6f;
constexpr float QSCALE = 0.125f * 1.4426950408889634f;
constexpr size_t KV_SLOT = (size_t)MTOK * 64 * 2;

constexpr size_t MiB = 1u << 20;
constexpr size_t WS_ROPE = 1 * MiB, WS_BIAS1 = 1 * MiB + 256 * 1024;
constexpr size_t WS_WGU1 = 2 * MiB, WS_WD1 = 13 * MiB, WS_WIN = 19 * MiB, WS_WA = 29 * MiB, WS_WC = 30 * MiB, WS_WOUT = 31 * MiB;
constexpr size_t WS_WGU2 = 33 * MiB, WS_WD2 = 44 * MiB, WS_WCK1 = 50 * MiB, WS_WCV1 = 51 * MiB, WS_SSP = 52 * MiB;
constexpr size_t WS_XB = 64 * MiB, WS_BIG = 192 * MiB;
constexpr size_t WS_HID = WS_BIG, WS_Q = WS_BIG, WS_KV = WS_BIG + 64 * MiB, WS_PCU = WS_BIG + 162 * MiB, WS_GB = WS_BIG + 226 * MiB;
constexpr size_t WS_MG = WS_BIG + 290 * MiB, WS_NG = WS_BIG + 546 * MiB, WS_AO = WS_BIG + 552 * MiB, WS_HC = WS_BIG + 616 * MiB;
constexpr size_t WS_KCC = WS_BIG + 624 * MiB, WS_VCC = WS_BIG + 625 * MiB, WS_MERGED = WS_BIG;
constexpr size_t WS_END = WS_BIG + 626 * MiB;

namespace pg8 {
constexpr int BM = 256, BK = 64, HALF = 128, HTB = HALF * BK * 2, STAGE_BYTES = 8 * HTB, NXCD = 8, WGM = 8;
DI int lds_byte(int r, int c) { const int st = (r >> 4) * 2 + (c >> 5), rr = r & 15, cc = c & 31, ob = rr * 64 + cc * 2; return st * 1024 + (ob ^ (((ob >> 9) & 1) << 5)); }
DI void stage_rc(int b, int& R, int& C) { const int st = b / 1024, sb = b % 1024, swz = sb ^ (((sb >> 9) & 1) << 5); R = (st >> 1) * 16 + swz / 64; C = (st & 1) * 32 + (swz % 64) / 2; }
DI int perm32(int rho) { const int n = rho >> 4, i = rho & 15; return 8 * (i >> 2) + 4 * n + (i & 3); }

struct Unit { int pm, pn, src; };
struct Gemm { const bf16_t* A0; const bf16_t* A1; const bf16_t* B0; const bf16_t* B1; int lda, ldb, K; };

template <bool CHAIN> struct StaticOrder {
    int nM, nN, nwg, G, c;
    DI void init(int M, int N, int G_, int c_) { nM = M / BM; nN = N / BM; nwg = nM * nN; G = G_; c = c_; }
    DI bool next(int i, Unit& u) const {
        const int it = CHAIN ? (i >> 1) : i; u.src = CHAIN ? (i & 1) : 0;
        const long L = (long)it * G + c; if (L >= nwg) return false;
        int wgid = (int)L; { const int q = nwg / NXCD, r = nwg % NXCD, xcd = wgid % NXCD, off = wgid / NXCD; wgid = (xcd < r ? xcd * (q + 1) : r * (q + 1) + (xcd - r) * q) + off; }
        const int nig = WGM * nN, gid = wgid / nig, fm = gid * WGM, gsz = (nM - fm) < WGM ? (nM - fm) : WGM;
        u.pm = fm + ((wgid % nig) % gsz); u.pn = (wgid % nig) / gsz; return true;
    }
};
struct CmpOrder {
    int c;
    DI bool next(int i, Unit& u) const { if (i > 0 || c >= 64) return false; u.pm = c & 31; u.pn = 0; u.src = c >> 5; return true; }
};

template <class Epi, class Sched>
DI void gemm_phase(LAS unsigned char* lds, const Gemm g, const Sched& S, const Epi& E) {
    const int tid = threadIdx.x, wid = __builtin_amdgcn_readfirstlane(tid >> 6), lane = tid & 63, wr = wid >> 2, wc = wid & 3, fr = lane & 15, fq = lane >> 4;
    const int K = g.K, nt = K / BK;
    unsigned voffA[2], voffB[2];
#pragma unroll
    for (int i = 0; i < 2; ++i) { int R, C; stage_rc(tid * 16 + i * 8192, R, C); const int Rb = Epi::PERM ? ((R & ~31) + perm32(R & 31)) : R;
        voffA[i] = (unsigned)(R * g.lda + C) * 2u; voffB[i] = (unsigned)(Rb * g.ldb + C) * 2u; }
    const size_t kstep = (size_t)(BK * 2);
    const size_t hstepA = (size_t)HALF * g.lda * 2, hstepB = (size_t)HALF * g.ldb * 2;
    const size_t tstepA = 2 * hstepA, tstepB = 2 * hstepB;
    const unsigned ldsw = (unsigned)wid * 1024u;
    const int aoff = lds_byte(wr * 64 + fr, fq * 8), boff = lds_byte(wc * 32 + fr, fq * 8);
#define PG8_SA(b, h) (((b) * 2 + (h)) * HTB)
#define PG8_SB(b, h) ((4 + (b) * 2 + (h)) * HTB)
#define PG8_STAGE(bufoff, gbase, voff) do { _Pragma("unroll") for (int _i = 0; _i < 2; ++_i) \
        __builtin_amdgcn_global_load_lds((const unsigned*)((const char*)(gbase) + (voff)[_i]), (LAS unsigned*)(lds + (bufoff) + ldsw + _i * 8192), 16, 0, 0); } while (0)
#define PG8_LDA(dst, b, h) do { _Pragma("unroll") for (int m = 0; m < 4; ++m) _Pragma("unroll") for (int k = 0; k < 2; ++k) dst[m][k] = *(const LAS bf16x8*)(lds + PG8_SA(b, h) + aoff + m * 2048 + k * 1024); } while (0)
#define PG8_LDB(dst, b, h) do { _Pragma("unroll") for (int n = 0; n < 2; ++n) _Pragma("unroll") for (int k = 0; k < 2; ++k) dst[n][k] = *(const LAS bf16x8*)(lds + PG8_SB(b, h) + boff + n * 2048 + k * 1024); } while (0)
#define PG8_MMA(ai, bj, At, Bt) do { __builtin_amdgcn_s_setprio(1); _Pragma("unroll") for (int m = 0; m < 4; ++m) _Pragma("unroll") for (int n = 0; n < 2; ++n) _Pragma("unroll") for (int k = 0; k < 2; ++k) \
        acc[ai][bj][m][n] = __builtin_amdgcn_mfma_f32_16x16x32_bf16(Bt[n][k], At[m][k], acc[ai][bj][m][n], 0, 0, 0); __builtin_amdgcn_s_setprio(0); } while (0)
#define PG8_WAIT_V(n) asm volatile("s_waitcnt vmcnt(" #n ")" ::: "memory")
#define PG8_WAIT_L(n) asm volatile("s_waitcnt lgkmcnt(" #n ")" ::: "memory")
#define PG8_BAR __builtin_amdgcn_s_barrier()
#define PG8_SCHED __builtin_amdgcn_sched_barrier(0)
    Unit cur, nxt; int ui = 0;
    if (!S.next(0, cur)) return;
    typename Epi::Pre pre;
    f32x4 acc[2][2][4][2];
#pragma unroll
    for (int a = 0; a < 2; ++a)
#pragma unroll
        for (int b = 0; b < 2; ++b)
#pragma unroll
            for (int m = 0; m < 4; ++m)
#pragma unroll
                for (int n = 0; n < 2; ++n) acc[a][b][m][n] = (f32x4){0.f, 0.f, 0.f, 0.f};
    bf16x8 At[4][2], B0[2][2], B1[2][2];
    const char* cA = (const char*)(cur.src ? g.A1 : g.A0) + (size_t)cur.pm * tstepA; const char* cB = (const char*)(cur.src ? g.B1 : g.B0) + (size_t)cur.pn * tstepB;
    PG8_STAGE(PG8_SB(0, 0), cB, voffB); PG8_STAGE(PG8_SB(0, 1), cB + hstepB, voffB); PG8_STAGE(PG8_SA(0, 0), cA, voffA); PG8_STAGE(PG8_SA(0, 1), cA + hstepA, voffA);
    if (wr == 1) PG8_BAR;
    PG8_WAIT_V(2); PG8_BAR;
    PG8_STAGE(PG8_SB(1, 0), cB + kstep, voffB); PG8_STAGE(PG8_SA(1, 0), cA + kstep, voffA); PG8_STAGE(PG8_SB(1, 1), cB + hstepB + kstep, voffB);
    PG8_WAIT_V(6); PG8_BAR;
    for (;;) {
        const bool has_next = S.next(ui + 1, nxt);
        E.pre(pre, cur, wr, fr);
        const char* nA = has_next ? (const char*)(nxt.src ? g.A1 : g.A0) + (size_t)nxt.pm * tstepA : cA; const char* nB = has_next ? (const char*)(nxt.src ? g.B1 : g.B0) + (size_t)nxt.pn * tstepB : cB;
        for (int t = 0; t < nt; t += 2) {
            const bool last = (t == nt - 2);
            const char* a1 = cA + (size_t)(t + 1) * kstep;
            const char* a2 = last ? nA : cA + (size_t)(t + 2) * kstep; const char* b2 = last ? nB : cB + (size_t)(t + 2) * kstep;
            const char* a3 = a2 + kstep; const char* b3 = b2 + kstep;
            PG8_LDB(B0, 0, 0); PG8_LDB(B1, 0, 1); PG8_SCHED; PG8_LDA(At, 0, 0); PG8_STAGE(PG8_SA(1, 1), a1 + hstepA, voffA);
            PG8_WAIT_V(8); PG8_WAIT_L(0); PG8_BAR; PG8_MMA(0, 0, At, B0); PG8_MMA(0, 1, At, B1); PG8_BAR; PG8_SCHED;
            PG8_LDA(At, 0, 1); PG8_STAGE(PG8_SB(0, 0), b2, voffB); PG8_STAGE(PG8_SB(0, 1), b2 + hstepB, voffB); PG8_STAGE(PG8_SA(0, 0), a2, voffA);
            PG8_WAIT_V(8); PG8_WAIT_L(0); PG8_BAR; PG8_MMA(1, 0, At, B0); PG8_MMA(1, 1, At, B1); PG8_BAR; PG8_SCHED;
            PG8_LDB(B0, 1, 0); PG8_LDB(B1, 1, 1); PG8_SCHED; PG8_LDA(At, 1, 0); PG8_STAGE(PG8_SA(0, 1), a2 + hstepA, voffA);
            PG8_WAIT_V(8); PG8_WAIT_L(0); PG8_BAR; PG8_MMA(0, 0, At, B0); PG8_MMA(0, 1, At, B1); PG8_BAR; PG8_SCHED;
            PG8_LDA(At, 1, 1); PG8_STAGE(PG8_SB(1, 0), b3, voffB); PG8_STAGE(PG8_SB(1, 1), b3 + hstepB, voffB); PG8_STAGE(PG8_SA(1, 0), a3, voffA);
            PG8_WAIT_V(8); PG8_WAIT_L(0); PG8_BAR; PG8_MMA(1, 0, At, B0); PG8_MMA(1, 1, At, B1); PG8_BAR; PG8_SCHED;
        }
        if (wr == 0) PG8_BAR;
        E(acc, cur, wr, wc, fr, fq, pre);
        if (!has_next) break;
        if (!(Epi::CHAIN && cur.src == 0)) {
#pragma unroll
            for (int a = 0; a < 2; ++a)
#pragma unroll
                for (int b = 0; b < 2; ++b)
#pragma unroll
                    for (int m = 0; m < 4; ++m)
#pragma unroll
                        for (int n = 0; n < 2; ++n) acc[a][b][m][n] = (f32x4){0.f, 0.f, 0.f, 0.f};
        }
        cur = nxt; cA = nA; cB = nB; ++ui;
        if (wr == 1) PG8_BAR;
    }
    PG8_WAIT_V(0);
    PG8_BAR;
#undef PG8_SA
#undef PG8_SB
#undef PG8_STAGE
#undef PG8_LDA
#undef PG8_LDB
#undef PG8_MMA
#undef PG8_WAIT_V
#undef PG8_WAIT_L
#undef PG8_BAR
#undef PG8_SCHED
}
}

typedef f32x4 Acc[2][2][4][2];

struct PreNone { };
struct PreRows { float v[8]; };
DI void load_rows(PreRows& pr, const float* ssq, const pg8::Unit& u, int wr, int fr) {
#pragma unroll
    for (int ai = 0; ai < 2; ++ai)
#pragma unroll
        for (int m = 0; m < 4; ++m) pr.v[ai * 4 + m] = ssq[u.pm * 256 + ai * 128 + wr * 64 + m * 16 + fr];
}
DI float msq_of(float ssq) { return ssq * (1.0f / DM) + NORM_EPS; }
DI void store8(bf16_t* p, const f32x4 v0, const f32x4 v1) {
    u32x4 w; w.x = pk2(v0[0], v0[1]); w.y = pk2(v0[2], v0[3]); w.z = pk2(v1[0], v1[1]); w.w = pk2(v1[2], v1[3]);
    *(u32x4*)p = w;
}

struct EpiGateUp {
    static constexpr bool PERM = true, CHAIN = false;
    typedef PreRows Pre;
    bf16_t* H; const float* ssq;
    DI void pre(Pre& pr, const pg8::Unit& u, int wr, int fr) const { load_rows(pr, ssq, u, wr, fr); }
    DI void operator()(Acc& acc, const pg8::Unit& u, int wr, int wc, int fr, int fq, const Pre& pr) const {
        const int col = u.pn * 128 + wc * 32 + fq * 8;
#pragma unroll
        for (int ai = 0; ai < 2; ++ai)
#pragma unroll
            for (int m = 0; m < 4; ++m) {
                const int row = u.pm * 256 + ai * 128 + wr * 64 + m * 16 + fr;
                const float msq = msq_of(pr.v[ai * 4 + m]), nrl = -1.4426950408889634f * __builtin_amdgcn_rsqf(msq);
                f32x4 h[2];
#pragma unroll
                for (int n = 0; n < 2; ++n)
#pragma unroll
                    for (int i = 0; i < 4; ++i) { const float ga = acc[ai][0][m][n][i], ua = acc[ai][1][m][n][i];
                        const float e = fast_exp2(ga * nrl); h[n][i] = (ga * ua) * fast_rcp(__builtin_fmaf(e, msq, msq)); }
                store8(H + (size_t)row * FF + col, h[0], h[1]);
            }
    }
};

template <bool RES_BF16, bool WRITE_F32, bool WRITE_XB> struct EpiResid {
    static constexpr bool PERM = true, CHAIN = false;
    typedef PreNone Pre;
    const float* res; float* out; bf16_t* xb; float* ssq; float coef;
    DI void pre(Pre&, const pg8::Unit&, int, int) const {}
    DI void operator()(Acc& acc, const pg8::Unit& u, int wr, int wc, int fr, int fq, const Pre&) const {
        const int col = u.pn * 256 + wc * 32 + fq * 8;
#pragma unroll
        for (int ai = 0; ai < 2; ++ai)
#pragma unroll
            for (int m = 0; m < 4; ++m) {
                const int row = u.pm * 256 + ai * 128 + wr * 64 + m * 16 + fr;
                float ss = 0.f;
#pragma unroll
                for (int bj = 0; bj < 2; ++bj) {
                    const size_t off = (size_t)row * DM + col + bj * 128;
                    f32x4 r0, r1;
                    if (RES_BF16) { const u32x4 rb = *(const u32x4*)(xb + off); r0 = (f32x4){bf_lo(rb.x), bf_hi(rb.x), bf_lo(rb.y), bf_hi(rb.y)}; r1 = (f32x4){bf_lo(rb.z), bf_hi(rb.z), bf_lo(rb.w), bf_hi(rb.w)}; }
                    else { r0 = *(const f32x4*)(res + off); r1 = *(const f32x4*)(res + off + 4); }
                    const f32x4 v0 = r0 + acc[ai][bj][m][0] * coef, v1 = r1 + acc[ai][bj][m][1] * coef;
                    if (WRITE_F32) { *(f32x4*)(out + off) = v0; *(f32x4*)(out + off + 4) = v1; }
                    if (WRITE_XB) { store8(xb + off, v0, v1);
                        ss += (v0[0] * v0[0] + v0[1] * v0[1]) + (v0[2] * v0[2] + v0[3] * v0[3]) + (v1[0] * v1[0] + v1[1] * v1[1]) + (v1[2] * v1[2] + v1[3] * v1[3]); }
                }
                if (WRITE_XB) { ss += __shfl_xor(ss, 16); ss += __shfl_xor(ss, 32); if (fq == 0) __hip_atomic_fetch_add(ssq + row, ss, __ATOMIC_RELAXED, __HIP_MEMORY_SCOPE_AGENT); }
            }
    }
};

struct EpiWin {
    static constexpr bool PERM = true, CHAIN = false;
    typedef PreRows Pre;
    const float* ssq; const float* rope; const float* qng; const float* kng;
    bf16_t* Q; bf16_t* KV; bf16_t* PCU; bf16_t* GB; bf16_t* MG; float* NG;
    DI void pre(Pre& pr, const pg8::Unit& u, int wr, int fr) const { load_rows(pr, ssq, u, wr, fr); }
    DI void operator()(Acc& acc, const pg8::Unit& u, int wr, int wc, int fr, int fq, const Pre& pr) const {
        const int pn = u.pn;
        if (pn < 5) {
            int do_norm, slot = 0, gidx = 0; const float* gain; float scale = 1.f;
            if (pn < 2) { do_norm = 1; gain = qng; scale = QSCALE; }
            else { const int idx = 4 * (pn - 2) + wc; slot = idx >> 1; gidx = idx & 1; do_norm = (slot == 2 || slot == 4) ? 1 : 0; gain = kng + (slot == 2 ? 64 : 128); }
            f32x4 gn[2][2];
#pragma unroll
            for (int bj = 0; bj < 2; ++bj)
#pragma unroll
                for (int n = 0; n < 2; ++n) gn[bj][n] = do_norm ? *(const f32x4*)(gain + 32 * bj + 8 * fq + 4 * n) : (f32x4){1.f, 1.f, 1.f, 1.f};
#pragma unroll
            for (int ai = 0; ai < 2; ++ai)
#pragma unroll
                for (int m = 0; m < 4; ++m) {
                    const int row = u.pm * 256 + ai * 128 + wr * 64 + m * 16 + fr;
                    const float rs = __builtin_amdgcn_rsqf(msq_of(pr.v[ai * 4 + m]));
                    f32x4 v[2][2];
#pragma unroll
                    for (int bj = 0; bj < 2; ++bj)
#pragma unroll
                        for (int n = 0; n < 2; ++n) v[bj][n] = acc[ai][bj][m][n] * rs;
                    if (do_norm) {
                        float ss = 0.f;
#pragma unroll
                        for (int bj = 0; bj < 2; ++bj)
#pragma unroll
                            for (int n = 0; n < 2; ++n) ss += (v[bj][n][0] * v[bj][n][0] + v[bj][n][1] * v[bj][n][1]) + (v[bj][n][2] * v[bj][n][2] + v[bj][n][3] * v[bj][n][3]);
                        ss += __shfl_xor(ss, 16); ss += __shfl_xor(ss, 32);
                        const float hr = __builtin_amdgcn_rsqf(ss * (1.0f / 64.0f) + NORM_EPS);
#pragma unroll
                        for (int bj = 0; bj < 2; ++bj)
#pragma unroll
                            for (int n = 0; n < 2; ++n) v[bj][n] = v[bj][n] * hr * gn[bj][n];
                        const int s = row & (SEQ - 1);
#pragma unroll
                        for (int n = 0; n < 2; ++n) {
                            f32x4 pr;
#pragma unroll
                            for (int i = 0; i < 4; ++i) pr[i] = __shfl_xor(v[0][n][i], 16);
                            if (fq < 2) {
                                const f32x4 cs = *(const f32x4*)(rope + s * 16 + 4 * n), sn = *(const f32x4*)(rope + s * 16 + 8 + 4 * n);
                                v[0][n] = (fq == 0) ? (v[0][n] * cs - pr * sn) : (v[0][n] * cs + pr * sn);
                            }
                        }
                    }
                    bf16_t* dst;
                    if (pn < 2) dst = Q + (size_t)row * 512 + (4 * pn + wc) * 64 + 8 * fq;
                    else { const int b = row >> 11, sq = row & (SEQ - 1); dst = KV + (size_t)slot * KV_SLOT + ((size_t)((b * 2 + gidx) * SEQ + sq)) * 64 + 8 * fq; }
#pragma unroll
                    for (int bj = 0; bj < 2; ++bj) store8(dst + 32 * bj, v[bj][0] * scale, v[bj][1] * scale);
                }
        } else if (pn < 9) {
            const int col = (pn - 5) * 128 + wc * 32 + fq * 8;
#pragma unroll
            for (int ai = 0; ai < 2; ++ai)
#pragma unroll
                for (int m = 0; m < 4; ++m) {
                    const int row = u.pm * 256 + ai * 128 + wr * 64 + m * 16 + fr;
                    const float rs = __builtin_amdgcn_rsqf(msq_of(pr.v[ai * 4 + m])), rs2 = rs * rs;
                    store8(PCU + (size_t)row * 512 + col, acc[ai][0][m][0] * acc[ai][1][m][0] * rs2, acc[ai][0][m][1] * acc[ai][1][m][1] * rs2);
                }
        } else if (pn < 11) {
            const int col = (pn - 9) * 256 + wc * 32 + fq * 8;
#pragma unroll
            for (int ai = 0; ai < 2; ++ai)
#pragma unroll
                for (int m = 0; m < 4; ++m) {
                    const int row = u.pm * 256 + ai * 128 + wr * 64 + m * 16 + fr;
                    const float rs = __builtin_amdgcn_rsqf(msq_of(pr.v[ai * 4 + m]));
#pragma unroll
                    for (int bj = 0; bj < 2; ++bj) store8(GB + (size_t)row * 512 + col + bj * 128, acc[ai][bj][m][0] * rs, acc[ai][bj][m][1] * rs);
                }
        } else if (pn < 19) {
            const int col = (pn - 11) * 128 + wc * 32 + fq * 8;
#pragma unroll
            for (int ai = 0; ai < 2; ++ai)
#pragma unroll
                for (int m = 0; m < 4; ++m) {
                    const int row = u.pm * 256 + ai * 128 + wr * 64 + m * 16 + fr;
                    const float nrl = -1.4426950408889634f * __builtin_amdgcn_rsqf(msq_of(pr.v[ai * 4 + m]));
                    f32x4 rr[2], gc[2];
#pragma unroll
                    for (int n = 0; n < 2; ++n)
#pragma unroll
                        for (int i = 0; i < 4; ++i) {
                            const float da = 1.0f + fast_exp2(acc[ai][0][m][n][i] * nrl), dc = 1.0f + fminf(fast_exp2(acc[ai][1][m][n][i] * nrl), 1e18f);
                            rr[n][i] = dc * fast_rcp(da); gc[n][i] = fast_rcp(dc);
                        }
                    store8(MG + (size_t)row * 2048 + col, rr[0], rr[1]);
                    store8(MG + (size_t)row * 2048 + 1024 + col, gc[0], gc[1]);
                }
        } else {
            if (wc == 0 && fq < 3) {
#pragma unroll
                for (int ai = 0; ai < 2; ++ai)
#pragma unroll
                    for (int m = 0; m < 4; ++m) {
                        const int row = u.pm * 256 + ai * 128 + wr * 64 + m * 16 + fr;
                        const float rs = __builtin_amdgcn_rsqf(msq_of(pr.v[ai * 4 + m]));
                        f32x4 s0, s1;
#pragma unroll
                        for (int i = 0; i < 4; ++i) { s0[i] = sigmoidf_(acc[ai][0][m][0][i] * rs); s1[i] = sigmoidf_(acc[ai][0][m][1][i] * rs); }
                        *(f32x4*)(NG + (size_t)row * 24 + 8 * fq) = s0; *(f32x4*)(NG + (size_t)row * 24 + 8 * fq + 4) = s1;
                    }
            }
        }
    }
};

struct EpiMerge {
    static constexpr bool PERM = true, CHAIN = true;
    typedef PreNone Pre;
    const bf16_t* MG; bf16_t* OUT;
    DI void pre(Pre&, const pg8::Unit&, int, int) const {}
    DI void operator()(Acc& acc, const pg8::Unit& u, int wr, int wc, int fr, int fq, const Pre&) const {
        const int col = u.pn * 256 + wc * 32 + fq * 8;
#pragma unroll
        for (int ai = 0; ai < 2; ++ai)
#pragma unroll
            for (int m = 0; m < 4; ++m) {
                const int row = u.pm * 256 + ai * 128 + wr * 64 + m * 16 + fr;
#pragma unroll
                for (int bj = 0; bj < 2; ++bj) {
                    const u32x4 gq = *(const u32x4*)(MG + (size_t)row * 2048 + (u.src ? 1024 : 0) + col + bj * 128);
                    const float c[8] = {bf_lo(gq.x), bf_hi(gq.x), bf_lo(gq.y), bf_hi(gq.y), bf_lo(gq.z), bf_hi(gq.z), bf_lo(gq.w), bf_hi(gq.w)};
                    if (u.src == 0) {
#pragma unroll
                        for (int e = 0; e < 8; ++e) acc[ai][bj][m][e >> 2][e & 3] *= c[e];
                    } else {
                        f32x4 v0, v1;
#pragma unroll
                        for (int i = 0; i < 4; ++i) { v0[i] = acc[ai][bj][m][0][i] * c[i]; v1[i] = acc[ai][bj][m][1][i] * c[4 + i]; }
                        store8(OUT + (size_t)row * DM + col + bj * 128, v0, v1);
                    }
                }
            }
    }
};

struct EpiCmp1 {
    static constexpr bool PERM = true, CHAIN = false;
    typedef PreNone Pre;
    const float* bias1; bf16_t* HC;
    DI void pre(Pre&, const pg8::Unit&, int, int) const {}
    DI void operator()(Acc& acc, const pg8::Unit& u, int wr, int wc, int fr, int fq, const Pre&) const {
        const int col = wc * 32 + fq * 8;
        bf16_t* base = HC + (size_t)u.src * 8192 * 256;
#pragma unroll
        for (int bj = 0; bj < 2; ++bj) {
            const f32x4 b0 = *(const f32x4*)(bias1 + u.src * 256 + col + bj * 128), b1 = *(const f32x4*)(bias1 + u.src * 256 + col + bj * 128 + 4);
#pragma unroll
            for (int ai = 0; ai < 2; ++ai)
#pragma unroll
                for (int m = 0; m < 4; ++m) {
                    const int row = u.pm * 256 + ai * 128 + wr * 64 + m * 16 + fr;
                    f32x4 v0 = acc[ai][bj][m][0] + b0, v1 = acc[ai][bj][m][1] + b1;
#pragma unroll
                    for (int i = 0; i < 4; ++i) { v0[i] = siluf_(v0[i]); v1[i] = siluf_(v1[i]); }
                    store8(base + (size_t)row * 256 + col + bj * 128, v0, v1);
                }
        }
    }
};

struct Args { const float* in[23]; float* out; unsigned char* ws; int ph_lo, ph_hi; };

enum { I_X = 0, I_F1G, I_F1WG, I_F1WU, I_F1WD, I_MIXG, I_WIN, I_QNG, I_KNG, I_PEK, I_PEV, I_CK1, I_CK2, I_CV1, I_CV2, I_CONVW, I_WA, I_WC, I_WOUT, I_F2G, I_F2WG, I_F2WU, I_F2WD };

DI void transpose_item(const float* src, int Nsrc, int nvalid, const float* gk, bf16_t* WT, int K, int n0, int k0, LAS float* scr, int lane) {
    {
        const int cc = lane & 7, kr = lane >> 3;
        f32x4 v[8];
#pragma unroll
        for (int i = 0; i < 8; ++i) { const int kk = 8 * i + kr;
            v[i] = (4 * cc < nvalid) ? *(const f32x4*)(src + (size_t)(k0 + kk) * Nsrc + 4 * cc) : (f32x4){0.f, 0.f, 0.f, 0.f}; }
        if (gk) {
#pragma unroll
            for (int i = 0; i < 8; ++i) v[i] = v[i] * gk[k0 + 8 * i + kr];
        }
#pragma unroll
        for (int i = 0; i < 8; ++i) { LAS float* d = scr + (8 * i + kr) * 33 + 4 * cc; d[0] = v[i][0]; d[1] = v[i][1]; d[2] = v[i][2]; d[3] = v[i][3]; }
    }
    asm volatile("s_waitcnt lgkmcnt(0)" ::: "memory");
    const int c = lane & 7;
#pragma unroll
    for (int j = 0; j < 4; ++j) { const int n = (lane >> 3) + 8 * j; const LAS float* s = scr + (8 * c) * 33 + n;
        u32x4 o; o.x = pk2(s[0 * 33], s[1 * 33]); o.y = pk2(s[2 * 33], s[3 * 33]); o.z = pk2(s[4 * 33], s[5 * 33]); o.w = pk2(s[6 * 33], s[7 * 33]);
        *(u32x4*)(WT + (size_t)(n0 + n) * K + k0 + 8 * c) = o; }
    asm volatile("s_waitcnt lgkmcnt(0)" ::: "memory");
}

DI void prologue_weights(const Args& a, LAS float* scr, int gw, int ngw, int lane) {
    unsigned char* ws = a.ws;
    constexpr int IT_GU = 16 * 176, IT_D = 44 * 32, IT_WIN = 16 * 160, IT_AC = 8 * 32, IT_OUT = 16 * 32, IT_CK = 32 * 8;
    constexpr int NITEMS = 2 * IT_GU + 2 * IT_D + IT_WIN + 2 * IT_AC + IT_OUT + 2 * IT_CK;
    for (int it = gw; it < NITEMS; it += ngw) {
        int r = it;
        if (r < 2 * IT_GU) {
            const int f = r / IT_GU; r -= f * IT_GU; const int nb = r % 176, kb = r / 176, n0 = nb * 32, pn = n0 >> 8, p = n0 & 255;
            const float* W = (p < 128) ? a.in[f ? I_F2WG : I_F1WG] : a.in[f ? I_F2WU : I_F1WU];
            transpose_item(W + pn * 128 + (p & 127), FF, 32, a.in[f ? I_F2G : I_F1G], (bf16_t*)(ws + (f ? WS_WGU2 : WS_WGU1)), DM, n0, kb * 64, scr, lane);
            continue;
        }
        r -= 2 * IT_GU;
        if (r < 2 * IT_D) {
            const int f = r / IT_D; r -= f * IT_D; const int nb = r % 32, kb = r / 32;
            transpose_item(a.in[f ? I_F2WD : I_F1WD] + nb * 32, DM, 32, nullptr, (bf16_t*)(ws + (f ? WS_WD2 : WS_WD1)), FF, nb * 32, kb * 64, scr, lane);
            continue;
        }
        r -= 2 * IT_D;
        if (r < IT_WIN) {
            const int nb = r % 160, kb = r / 160, n0 = nb * 32, pn = n0 >> 8, p = n0 & 255, bj = p >> 7, wc = (p & 127) >> 5;
            int sc, nv = 32;
            if (pn < 2) sc = (4 * pn + wc) * 64 + 32 * bj;
            else if (pn < 5) sc = 512 + (4 * (pn - 2) + wc) * 64 + 32 * bj;
            else if (pn < 9) sc = 1304 + 512 + bj * 512 + (pn - 5) * 128 + wc * 32;
            else if (pn < 11) sc = 1304 + (pn - 9) * 256 + p;
            else if (pn < 19) sc = 2840 + bj * 1024 + (pn - 11) * 128 + wc * 32;
            else { sc = 1280; nv = (p == 0) ? 24 : 0; }
            transpose_item(a.in[I_WIN] + sc, 4888, nv, a.in[I_MIXG], (bf16_t*)(ws + WS_WIN), DM, n0, kb * 64, scr, lane);
            continue;
        }
        r -= IT_WIN;
        if (r < 2 * IT_AC) {
            const int f = r / IT_AC; r -= f * IT_AC; const int nb = r % 32, kb = r / 32;
            transpose_item(a.in[f ? I_WC : I_WA] + nb * 32, DM, 32, nullptr, (bf16_t*)(ws + (f ? WS_WC : WS_WA)), 512, nb * 32, kb * 64, scr, lane);
            continue;
        }
        r -= 2 * IT_AC;
        if (r < IT_OUT) {
            const int nb = r % 32, kb = r / 32;
            transpose_item(a.in[I_WOUT] + nb * 32, DM, 32, nullptr, (bf16_t*)(ws + WS_WOUT), DM, nb * 32, kb * 64, scr, lane);
            continue;
        }
        r -= IT_OUT;
        {
            const int f = r / IT_CK; r -= f * IT_CK; const int nb = r % 8, kb = r / 8;
            transpose_item(a.in[f ? I_CV1 : I_CK1] + nb * 32, 256, 32, nullptr, (bf16_t*)(ws + (f ? WS_WCV1 : WS_WCK1)), 2048, nb * 32, kb * 64, scr, lane);
        }
    }
}

DI void sincos_d(double x, float& s, float& c) {
    const double k = __builtin_rint(x * 0.63661977236758134308);
    double r = x - k * 1.5707963267948966192; r -= k * 6.123233995736766036e-17;
    const double r2 = r * r;
    const double sp = r * (1.0 + r2 * (-1.0 / 6 + r2 * (1.0 / 120 + r2 * (-1.0 / 5040 + r2 * (1.0 / 362880 + r2 * (-1.0 / 39916800 + r2 * (1.0 / 6227020800.0)))))));
    const double cp = 1.0 + r2 * (-0.5 + r2 * (1.0 / 24 + r2 * (-1.0 / 720 + r2 * (1.0 / 40320 + r2 * (-1.0 / 3628800 + r2 * (1.0 / 479001600.0 + r2 * (-1.0 / 87178291200.0)))))));
    const int q = ((int)k) & 3;
    const double ss = (q == 0) ? sp : (q == 1) ? cp : (q == 2) ? -sp : -cp;
    const double cc = (q == 0) ? cp : (q == 1) ? -sp : (q == 2) ? -cp : sp;
    s = (float)ss; c = (float)cc;
}

DI void phase_prologue(const Args& a, LAS unsigned char* lds, int vcu, int G) {
    const int tid = threadIdx.x, lane = tid & 63, wave = tid >> 6;
    const int gw = vcu * 8 + wave, ngw = G * 8;
    unsigned char* ws = a.ws;
    for (int wv = gw; wv < 256 + 512; wv += ngw) {
        if (wv < 256) {
            float* rope = (float*)(ws + WS_ROPE);
            const int e = wv * 64 + lane, s = e >> 3, j = e & 7;
            float f = 1.0f;
            f = (j == 1) ? 0.1939227432012558f : f; f = (j == 2) ? 0.03760603070259094f : f; f = (j == 3) ? 0.007292664609849453f : f; f = (j == 4) ? 0.0014142135623842478f : f;
            f = (j == 5) ? 0.00027424818836152554f : f; f = (j == 6) ? 5.3182957344688475e-05f : f; f = (j == 7) ? 1.0313385246263351e-05f : f;
            const float ang = (float)s * f; float sn, cs; sincos_d((double)ang, sn, cs);
            rope[s * 16 + j] = cs; rope[s * 16 + 8 + j] = sn;
        } else {
            const int o = wv - 256, src = o >> 8, n = o & 255; const float* pe = a.in[src ? I_PEV : I_PEK]; const float* w1 = a.in[src ? I_CV1 : I_CK1];
            float acc = 0.f;
#pragma unroll 8
            for (int i = 0; i < 32; ++i) { const int k = i * 64 + lane; acc += pe[k] * w1[(size_t)k * 256 + n]; }
            acc = wave_sum(acc);
            if (lane == 0) ((float*)(ws + WS_BIAS1))[o] = acc;
        }
    }
    prologue_weights(a, (LAS float*)(lds + wave * 16384), gw, ngw, lane);
    const float* x = a.in[I_X]; bf16_t* xb = (bf16_t*)(ws + WS_XB); float* ssqA = (float*)(ws + WS_SSP);
    for (int m = gw; m < MTOK; m += 4 * ngw) {
        f32x4 v[4][4]; float sq[4];
#pragma unroll
        for (int r = 0; r < 4; ++r) { const int mr = m + r * ngw; const f32x4* xr = (const f32x4*)(x + (size_t)(mr < MTOK ? mr : m) * DM) + lane;
#pragma unroll
            for (int j = 0; j < 4; ++j) v[r][j] = xr[64 * j]; }
#pragma unroll
        for (int r = 0; r < 4; ++r) { float s = 0.f;
#pragma unroll
            for (int j = 0; j < 4; ++j) s += (v[r][j][0] * v[r][j][0] + v[r][j][1] * v[r][j][1]) + (v[r][j][2] * v[r][j][2] + v[r][j][3] * v[r][j][3]);
            sq[r] = wave_sum(s); }
#pragma unroll
        for (int r = 0; r < 4; ++r) { const int mr = m + r * ngw;
            if (mr < MTOK) {
                u32x2* o8 = (u32x2*)(xb + (size_t)mr * DM) + lane;
#pragma unroll
                for (int j = 0; j < 4; ++j) { u32x2 w; w.x = pk2(v[r][j][0], v[r][j][1]); w.y = pk2(v[r][j][2], v[r][j][3]); o8[64 * j] = w; }
                if (lane < 3) ssqA[(size_t)lane * MTOK + mr] = (lane == 0) ? sq[r] : 0.f;
            } }
    }
}

DI void conv_pass(const Args& a, int gw, int ngw, int lane) {
    const bf16_t* P = (const bf16_t*)(a.ws + WS_PCU); bf16_t* GB = (bf16_t*)(a.ws + WS_GB);
    const float* cw = a.in[I_CONVW];
    float w0[8], w1[8], w2[8];
#pragma unroll
    for (int e = 0; e < 8; ++e) { w0[e] = cw[8 * lane + e]; w1[e] = cw[512 + 8 * lane + e]; w2[e] = cw[1024 + 8 * lane + e]; }
    for (int run = gw; run < MTOK / 16; run += ngw) {
        const int t0 = run * 16; const bool first = (t0 & (SEQ - 1)) == 0;
        float p2[8], p1[8];
        { u32x4 z = {0u, 0u, 0u, 0u}; u32x4 r2 = z, r1 = z;
          if (!first) { r2 = *(const u32x4*)(P + (size_t)(t0 - 2) * 512 + 8 * lane); r1 = *(const u32x4*)(P + (size_t)(t0 - 1) * 512 + 8 * lane); }
          p2[0] = bf_lo(r2.x); p2[1] = bf_hi(r2.x); p2[2] = bf_lo(r2.y); p2[3] = bf_hi(r2.y); p2[4] = bf_lo(r2.z); p2[5] = bf_hi(r2.z); p2[6] = bf_lo(r2.w); p2[7] = bf_hi(r2.w);
          p1[0] = bf_lo(r1.x); p1[1] = bf_hi(r1.x); p1[2] = bf_lo(r1.y); p1[3] = bf_hi(r1.y); p1[4] = bf_lo(r1.z); p1[5] = bf_hi(r1.z); p1[6] = bf_lo(r1.w); p1[7] = bf_hi(r1.w); }
#pragma unroll 4
        for (int i = 0; i < 16; ++i) {
            const size_t off = (size_t)(t0 + i) * 512 + 8 * lane;
            const u32x4 r0 = *(const u32x4*)(P + off), gb = *(const u32x4*)(GB + off);
            const float p0[8] = {bf_lo(r0.x), bf_hi(r0.x), bf_lo(r0.y), bf_hi(r0.y), bf_lo(r0.z), bf_hi(r0.z), bf_lo(r0.w), bf_hi(r0.w)};
            const float g[8] = {bf_lo(gb.x), bf_hi(gb.x), bf_lo(gb.y), bf_hi(gb.y), bf_lo(gb.z), bf_hi(gb.z), bf_lo(gb.w), bf_hi(gb.w)};
            float c[8];
#pragma unroll
            for (int e = 0; e < 8; ++e) { c[e] = g[e] * (w0[e] * p2[e] + w1[e] * p1[e] + w2[e] * p0[e]); p2[e] = p1[e]; p1[e] = p0[e]; }
            u32x4 o; o.x = pk2(c[0], c[1]); o.y = pk2(c[2], c[3]); o.z = pk2(c[4], c[5]); o.w = pk2(c[6], c[7]);
            *(u32x4*)(GB + off) = o;
        }
    }
}

DI void cmp2_pass(const Args& a, LAS unsigned char* lds, int vcu, int G) {
    const int tid = threadIdx.x, lane = tid & 63, wave = tid >> 6;
    const bf16_t* HC = (const bf16_t*)(a.ws + WS_HC);
    const float kg = a.in[I_KNG][lane];
    LAS float* w2s = (LAS float*)lds;
    for (int unit = vcu; unit < 256; unit += G) {
        const int src = unit >> 7, r0 = (unit & 127) * 64 + wave * 8;
        const float* w2 = a.in[src ? I_CV2 : I_CK2];
        __syncthreads();
#pragma unroll
        for (int i = 0; i < 8; ++i) *(LAS f32x4*)(w2s + (i * 512 + tid) * 4) = *(const f32x4*)(w2 + (i * 512 + tid) * 4);
        __syncthreads();
#pragma unroll 1
        for (int g4 = 0; g4 < 2; ++g4) {
            const int rb = r0 + 4 * g4;
            const bf16_t* h = HC + (size_t)src * 8192 * 256 + (size_t)rb * 256;
            float acc[4] = {0.f, 0.f, 0.f, 0.f};
#pragma unroll 2
            for (int jb = 0; jb < 32; ++jb) {
                u32x4 h8[4];
#pragma unroll
                for (int r = 0; r < 4; ++r) h8[r] = *(const u32x4*)(h + r * 256 + 8 * jb);
                float wv[8];
#pragma unroll
                for (int e = 0; e < 8; ++e) wv[e] = w2s[(8 * jb + e) * 64 + lane];
#pragma unroll
                for (int r = 0; r < 4; ++r) {
                    acc[r] += bf_lo(h8[r].x) * wv[0]; acc[r] += bf_hi(h8[r].x) * wv[1]; acc[r] += bf_lo(h8[r].y) * wv[2]; acc[r] += bf_hi(h8[r].y) * wv[3];
                    acc[r] += bf_lo(h8[r].z) * wv[4]; acc[r] += bf_hi(h8[r].z) * wv[5]; acc[r] += bf_lo(h8[r].w) * wv[6]; acc[r] += bf_hi(h8[r].w) * wv[7];
                }
            }
#pragma unroll
            for (int r = 0; r < 4; ++r) {
                const int row = rb + r, n = row & 127;
                float v = acc[r];
                if (src == 0) { const float ss = wave_sum(v * v); v = v * __builtin_amdgcn_rsqf(ss * (1.0f / 64.0f) + NORM_EPS) * kg; }
                if (n == 127) v = 0.f;
                bf16_t* dst = (bf16_t*)(a.ws + (src ? WS_VCC : WS_KCC)) + (size_t)row * 64 + lane;
                *dst = (bf16_t)(pk2(v, 0.f) & 0xffffu);
            }
        }
    }
}

#define MFMA32(a, b, c) __builtin_amdgcn_mfma_f32_32x32x16_bf16((a), (b), (c), 0, 0, 0)
constexpr int VT_PITCH = 72;
constexpr int LDS_VT = 8192, ATT_BUF = 16384, LDS_IMP = 65536, LDS_VAL = 99328, LDS_MSK = 107520, LDS_LIST = 108544, LDS_GATE = 109568, LDS_SCL = 115712, LDS_STG = 65536, IMP_PITCH = 33;

DI float half_max(float v) { auto rr = __builtin_amdgcn_permlane32_swap(__float_as_uint(v), __float_as_uint(v), false, false); return fmaxf(__uint_as_float(rr[0]), __uint_as_float(rr[1])); }
DI float half_sum(float v) { auto rr = __builtin_amdgcn_permlane32_swap(__float_as_uint(v), __float_as_uint(v), false, false); return __uint_as_float(rr[0]) + __uint_as_float(rr[1]); }
typedef short s16x4 __attribute__((ext_vector_type(4)));
typedef short v4i16_t __attribute__((ext_vector_type(4)));
DI void attn_tile(LAS const unsigned char* Ks, LAS const unsigned char* VT, const bf16x8 (&qf)[4], int ql, int hi,
                  bool need_mask, bool col_en, int lo_b, int hi_b, float& m_ref, float& l_run, f32x16 (&o)[2], f32x16 (&sp)[2]) {
    const int lane_ = ql + 32 * hi;
    const float bias = col_en ? -m_ref : -INFINITY;
    const bool plain = __all(col_en && (m_ref == 0.f));
#pragma unroll
    for (int p = 0; p < 2; ++p) {
        bf16x8 kf[4];
#pragma unroll
        for (int d0 = 0; d0 < 4; ++d0) { const int c = 2 * d0 + hi; kf[d0] = *(LAS const bf16x8*)(Ks + c * 1024 + ((ql + 32 * p) << 4)); }
        f32x16 acc;
        if (plain) {
#pragma unroll
            for (int r = 0; r < 16; ++r) acc[r] = 0.f;
            { __builtin_amdgcn_s_setprio(1);
#pragma unroll
              for (int d0 = 0; d0 < 4; ++d0) acc = MFMA32(kf[d0], qf[d0], acc);
              __builtin_amdgcn_s_setprio(0); }
        } else {
#pragma unroll
            for (int r = 0; r < 16; ++r) acc[r] = bias;
            { __builtin_amdgcn_s_setprio(1);
#pragma unroll
              for (int d0 = 0; d0 < 4; ++d0) acc = MFMA32(kf[d0], qf[d0], acc);
              __builtin_amdgcn_s_setprio(0); }
        }
        sp[p] = acc;
    }
    if (need_mask) {
#pragma unroll
        for (int p = 0; p < 2; ++p)
#pragma unroll
            for (int r = 0; r < 16; ++r) { const int kvl = 32 * p + (r & 3) + 8 * (r >> 2) + 4 * hi; const bool ok = (kvl <= hi_b) && (kvl > lo_b); sp[p][r] = ok ? sp[p][r] : -INFINITY; }
    }
    float tm = fmaxf(fmaxf(sp[0][0], sp[0][1]), sp[1][0]);
#pragma unroll
    for (int r = 2; r < 16; r += 2) tm = fmaxf(fmaxf(tm, sp[0][r]), sp[0][r + 1]);
#pragma unroll
    for (int r = 1; r < 15; r += 2) tm = fmaxf(fmaxf(tm, sp[1][r]), sp[1][r + 1]);
    tm = fmaxf(tm, sp[1][15]);
    tm = half_max(tm);
    if (__any((tm > 16.f) || ((tm < -16.f) && (tm > -INFINITY)))) {
        const bool up = tm > 16.f;
        const bool dn = (tm < -16.f) && (tm > -INFINITY) && (half_sum(l_run) == 0.f);
        const float dlt = (up || dn) ? tm : 0.f;
        const float alpha = up ? fast_exp2(-dlt) : 1.0f;
        l_run *= alpha; m_ref += dlt;
#pragma unroll
        for (int r = 0; r < 16; ++r) { o[0][r] *= alpha; o[1][r] *= alpha; sp[0][r] -= dlt; sp[1][r] -= dlt; }
    }
    f32x2_t ps = {0.f, 0.f};
#pragma unroll
    for (int r = 0; r < 16; ++r) { const float e0 = fast_exp2(sp[0][r]), e1 = fast_exp2(sp[1][r]); sp[0][r] = e0; sp[1][r] = e1; ps += (f32x2_t){e0, e1}; }
    l_run += ps[0] + ps[1];
    bf16x8 pk[2][2];
#pragma unroll
    for (int p = 0; p < 2; ++p)
#pragma unroll
        for (int s = 0; s < 2; ++s) { u32x4 w; w.x = pk2(sp[p][8 * s], sp[p][8 * s + 1]); w.y = pk2(sp[p][8 * s + 2], sp[p][8 * s + 3]); w.z = pk2(sp[p][8 * s + 4], sp[p][8 * s + 5]); w.w = pk2(sp[p][8 * s + 6], sp[p][8 * s + 7]); pk[p][s] = __builtin_bit_cast(bf16x8, w); }
    LAS const unsigned char* vb = VT + ((lane_ >> 4) & 1) * 32 + (lane_ & 3) * 8 + (4 * hi + ((lane_ & 15) >> 2)) * 64;
#pragma unroll
    for (int dh = 0; dh < 2; ++dh) {
        bf16x8 vf[4];
#pragma unroll
        for (int ks = 0; ks < 4; ++ks) {
            const s16x4 lo = __builtin_bit_cast(s16x4, __builtin_amdgcn_ds_read_tr16_b64_v4i16((LAS v4i16_t*)(vb + dh * 4096 + ks * 1024)));
            const s16x4 hh = __builtin_bit_cast(s16x4, __builtin_amdgcn_ds_read_tr16_b64_v4i16((LAS v4i16_t*)(vb + dh * 4096 + ks * 1024 + 512)));
            vf[ks] = (bf16x8){lo[0], lo[1], lo[2], lo[3], hh[0], hh[1], hh[2], hh[3]};
        }
        __builtin_amdgcn_s_setprio(1);
#pragma unroll
        for (int ks = 0; ks < 4; ++ks) o[dh] = MFMA32(vf[ks], pk[ks >> 1][ks & 1], o[dh]);
        __builtin_amdgcn_s_setprio(0);
    }
}

DI void glds16(const void* gsrc, unsigned lds_dst) { unsigned keep;
    asm volatile("s_mov_b32 %0, m0\n\ts_mov_b32 m0, %2\n\ts_nop 0\n\tglobal_load_lds_dwordx4 %1, off\n\ts_mov_b32 m0, %0" : "=&s"(keep) : "v"(gsrc), "s"(lds_dst) : "memory"); }

DI void attn_unit(LAS unsigned char* lds, const Args& a, int bg, int qt) {
    const int tid = threadIdx.x, lane = tid & 63, w = __builtin_amdgcn_readfirstlane(tid >> 6);
    const int hl = w >> 1, qs = w & 1, ql = lane & 31, hi = lane >> 5, qloc = 32 * qs + ql;
    const int b = bg >> 1, g = bg & 1, head = g * 4 + hl;
    const size_t tok = (size_t)b * SEQ + qt * 64 + qloc;
    const bf16_t* Qb = (const bf16_t*)(a.ws + WS_Q); const bf16_t* KVb = (const bf16_t*)(a.ws + WS_KV);
    const float* NG = (const float*)(a.ws + WS_NG); bf16_t* AO = (bf16_t*)(a.ws + WS_AO);
    bf16x8 qf[4];
    { const bf16_t* qp = Qb + tok * 512 + head * 64 + hi * 8;
#pragma unroll
      for (int d0 = 0; d0 < 4; ++d0) qf[d0] = *(const bf16x8*)(qp + 16 * d0); }
    LAS float* GT = (LAS float*)(lds + LDS_GATE) + tid;
    GT[0] = NG[tok * 24 + head]; GT[512] = NG[tok * 24 + 8 + head]; GT[1024] = NG[tok * 24 + 16 + head];
    LAS float* IMP = (LAS float*)(lds + LDS_IMP); LAS float* VAL = (LAS float*)(lds + LDS_VAL);
    LAS unsigned* MSK = (LAS unsigned*)(lds + LDS_MSK); LAS int* LIST = (LAS int*)(lds + LDS_LIST);
    const unsigned lds_base = (unsigned)(uintptr_t)lds;
    const size_t kofs = (size_t)lane * 64 + w * 8;
    const size_t vofs = (size_t)(16 * (w & 3) + (lane >> 2)) * 64 + 32 * (w >> 2) + 8 * (lane & 3);
#define DMA_TILE(Kp, Vp, slot) do { \
        glds16((Kp) + kofs, (unsigned)__builtin_amdgcn_readfirstlane((int)(lds_base + (unsigned)((slot) * ATT_BUF + w * 1024)))); \
        glds16((Vp) + vofs, (unsigned)__builtin_amdgcn_readfirstlane((int)(lds_base + (unsigned)((slot) * ATT_BUF + LDS_VT + w * 1024)))); } while (0)
#define WAIT_VM(n) asm volatile("s_waitcnt vmcnt(" #n ")" ::: "memory")
#define LBAR() do { asm volatile("s_waitcnt lgkmcnt(0)" ::: "memory"); __builtin_amdgcn_s_barrier(); asm volatile("" ::: "memory"); } while (0)

    const bf16_t* KC = (const bf16_t*)(a.ws + WS_KCC) + (size_t)bg * 8192;
    const bf16_t* KS = KVb + 2 * KV_SLOT + (size_t)bg * SEQ * 64;
    constexpr size_t VC_OFF = (WS_VCC - WS_KCC) / 2;

    f32x16 oacc[2], o[2], sp[2];
#pragma unroll
    for (int r = 0; r < 16; ++r) { oacc[0][r] = 0.f; oacc[1][r] = 0.f; o[0][r] = 0.f; o[1][r] = 0.f; }
    float m_ref = 0.f, l_run = 0.f;
    const int pos = qt * 64 + qloc;

    float mu0 = 0.f, xcross = 0.f;
    LAS float* ip = IMP + (hl * 64 + qloc) * IMP_PITCH;
    const bool two_cmp = qt >= 16;
    DMA_TILE(KC, KC + VC_OFF, 0);
    if (two_cmp) DMA_TILE(KC + 4096, KC + VC_OFF + 4096, 1);
    DMA_TILE(KS, KS + KV_SLOT, 2);
    WAIT_VM(0);
    __syncthreads();
#pragma unroll
    for (int ct = 0; ct < 2; ++ct) {
        if (ct == 0 || two_cmp) {
            const int hb = ((pos - 31) >> 4) - 64 * ct;
            LAS const unsigned char* kb = lds + ct * ATT_BUF;
            attn_tile(kb, kb + LDS_VT, qf, ql, hi, true, true, -1, hb, m_ref, l_run, o, sp);
            if (ct == 0) mu0 = m_ref;
            float prev = 0.f;
            if (two_cmp)
#pragma unroll
            for (int kk = 0; kk < 8; ++kk) { const int p = kk >> 2, k = kk & 3;
                const float xk = __shfl_xor(sp[p][4 * k + 3], 32);
                const float e4 = (sp[p][4 * k] + sp[p][4 * k + 1]) + (sp[p][4 * k + 2] + sp[p][4 * k + 3]);
                ip[16 * ct + 2 * kk + hi] = e4 + (hi ? xk : prev);
                prev = xk; asm volatile("" : "+v"(prev)); }
            if (ct == 0) xcross = prev;
        }
    }
    {
        const float lt = half_sum(l_run);
        const float inv = lt > 0.f ? 1.0f / lt : 0.f;
        const float gi = GT[0] * inv;
#pragma unroll
        for (int r = 0; r < 16; ++r) { oacc[0][r] += gi * o[0][r]; oacc[1][r] += gi * o[1][r]; o[0][r] = 0.f; o[1][r] = 0.f; }
        const float f0 = fast_exp2(mu0 - m_ref) * inv;
        if (two_cmp && hi == 0) { LAS float* sc = (LAS float*)(lds + LDS_SCL) + (hl * 64 + qloc) * 3; sc[0] = f0; sc[1] = inv; sc[2] = xcross * f0; }
        m_ref = 0.f; l_run = 0.f;
    }
    __syncthreads();
    const unsigned causal_all = (qt == 31) ? 0xffffffffu : ((1u << (qt + 1)) - 1u);
    if (two_cmp) {
        const int j = tid & 31;
        LAS const float* SCL = (LAS const float*)(lds + LDS_SCL);
#pragma unroll
        for (int it = 0; it < 4; ++it) { const int q = (tid >> 5) + 16 * it;
            float v = 0.f;
#pragma unroll
            for (int h = 0; h < 4; ++h) { const int hq = h * 64 + q; const float sc = SCL[hq * 3 + (j >> 4)]; v += IMP[hq * IMP_PITCH + j] * sc + ((j == 16) ? SCL[hq * 3 + 2] : 0.f); }
            const bool forced = (j == 0) || (j == qt) || (j == qt - 1);
            v = forced ? 1e4f : (j > qt ? -1.0f : v);
            VAL[q * 32 + j] = v; }
        __syncthreads();
        const unsigned causal_bits = (qt == 31) ? 0xffffffffu : ((1u << (qt + 1)) - 1u);
#pragma unroll
        for (int it = 0; it < 4; ++it) { const int q = (tid >> 5) + 16 * it;
            const float v = VAL[q * 32 + j]; int cnt = 0;
#pragma unroll 8
            for (int jj = 0; jj < 32; ++jj) { const float ov = VAL[q * 32 + jj]; cnt += ((ov > v) || (ov == v && jj < j)) ? 1 : 0; }
            const unsigned long long bal = __ballot(cnt < 16);
            const unsigned mk = ((lane < 32) ? (unsigned)bal : (unsigned)(bal >> 32)) & causal_bits;
            if ((lane & 31) == 0) MSK[q] = mk; }
        __syncthreads();
        if (w == 0) {
            int ln = lane; asm volatile("" : "+v"(ln));
            unsigned U = MSK[ln];
#pragma unroll
            for (int of = 1; of < 64; of <<= 1) U |= (unsigned)__shfl_xor((int)U, of);
            const int n = __popc(U), j0 = qt - 8 < 0 ? 0 : qt - 8;
            if (ln < 32) { if ((U >> ln) & 1u) LIST[__popc(U & ((1u << ln) - 1u))] = ln; }
            else if (j0 + (ln - 32) <= qt) LIST[n + ln - 32] = j0 + (ln - 32);
            if (ln == 0) { LIST[64] = n; LIST[65] = n + (qt - j0 + 1); }
        }
        __syncthreads();
    } else {
        if (w == 0) {
            int ln = lane; asm volatile("" : "+v"(ln));
            const int n = qt + 1, j0 = qt - 8 < 0 ? 0 : qt - 8;
            if (ln < 32) { if (ln <= qt) LIST[ln] = ln; }
            else if (j0 + (ln - 32) <= qt) LIST[n + ln - 32] = j0 + (ln - 32);
            if (ln == 0) { LIST[64] = n; LIST[65] = n + (qt - j0 + 1); }
        }
        __syncthreads();
    }
    const unsigned mask_q = two_cmp ? MSK[qloc] : causal_all;
    const int nsel = LIST[64], ntile = LIST[65];
#define TILE_SRC(ii, kp, vp) do { const int jn_ = LIST[(ii)]; const bool ns_ = (ii) < nsel; kp = KS + (ns_ ? (size_t)0 : 2 * KV_SLOT) + (size_t)jn_ * 4096; vp = kp + KV_SLOT; } while (0)
    if (ntile > 1) { const bf16_t* kp; const bf16_t* vp; TILE_SRC(1, kp, vp); DMA_TILE(kp, vp, 3); }
    if (ntile > 2) { const bf16_t* kp; const bf16_t* vp; TILE_SRC(2, kp, vp); DMA_TILE(kp, vp, 0); }
    for (int i = 0; i < ntile; ++i) {
        const int j = LIST[i]; const bool is_sel = i < nsel;
        if (i + 2 < ntile) WAIT_VM(4); else if (i + 1 < ntile) WAIT_VM(2); else WAIT_VM(0);
        LBAR();
        if (i + 3 < ntile) { const bf16_t* kp; const bf16_t* vp; TILE_SRC(i + 3, kp, vp); DMA_TILE(kp, vp, (i + 1) & 3); }
        if (i == nsel) {
            const float lt = half_sum(l_run); const float gi = GT[512] / lt;
#pragma unroll
            for (int r = 0; r < 16; ++r) { oacc[0][r] += gi * o[0][r]; oacc[1][r] += gi * o[1][r]; o[0][r] = 0.f; o[1][r] = 0.f; }
            m_ref = 0.f; l_run = 0.f;
        }
        bool need_mask, col_en = true; int lo_b = -1, hi_b = 63;
        if (is_sel) { need_mask = (j == qt); if (j == qt) hi_b = qloc; col_en = ((mask_q >> j) & 1u) != 0u; }
        else { need_mask = (j == qt) || (j == qt - 8); if (j == qt) hi_b = qloc; if (j == qt - 8) lo_b = qloc; }
        LAS const unsigned char* kb = lds + ((i + 2) & 3) * ATT_BUF;
        attn_tile(kb, kb + LDS_VT, qf, ql, hi, need_mask, col_en, lo_b, hi_b, m_ref, l_run, o, sp);
    }
#undef TILE_SRC
    {
        const float lt = half_sum(l_run); const float gi = GT[1024] / lt;
#pragma unroll
        for (int r = 0; r < 16; ++r) { oacc[0][r] += gi * o[0][r]; oacc[1][r] += gi * o[1][r]; }
    }
    {
        LAS bf16_t* stg = (LAS bf16_t*)(lds + LDS_STG + w * 4608);
#pragma unroll
        for (int dh = 0; dh < 2; ++dh)
#pragma unroll
            for (int r = 0; r < 16; r += 2) {
                const int d = 32 * dh + (r & 3) + 8 * (r >> 2) + 4 * hi;
                *(LAS unsigned*)(stg + ql * VT_PITCH + d) = pk2(oacc[dh][r], oacc[dh][r + 1]);
            }
        asm volatile("s_waitcnt lgkmcnt(0)" ::: "memory");
        bf16_t* dst = AO + ((size_t)b * SEQ + qt * 64 + 32 * qs) * 512 + head * 64;
#pragma unroll
        for (int i2 = 0; i2 < 4; ++i2) { const int row = i2 * 8 + (lane >> 3), ch = lane & 7; const u32x4 v = *(LAS const u32x4*)(stg + row * VT_PITCH + ch * 8); *(u32x4*)(dst + (size_t)row * 512 + ch * 8) = v; }
    }
#undef DMA_TILE
#undef WAIT_VM
#undef LBAR
}


#define XB_TMO      128
#define XB_XCNT(j)  (256  + 64 * (j))
#define XB_XSUB(j)  (1280 + 64 * (j))
#define XB_XGEN(j)  (2304 + 64 * (j))
#define XB_TOP      3328
#define XB_TOPGEN   3392
#define XCD_BAR_WORDS 3456
#define XB_SPIN_CAP (1u << 20)
DI unsigned xb_ld(unsigned* p)              { return __hip_atomic_load(p, __ATOMIC_RELAXED, __HIP_MEMORY_SCOPE_AGENT); }
DI unsigned xb_add(unsigned* p, unsigned v) { return __hip_atomic_fetch_add(p, v, __ATOMIC_RELAXED, __HIP_MEMORY_SCOPE_AGENT); }
DI unsigned xb_xcc_id() { return (unsigned)__builtin_amdgcn_s_getreg((3 << 11) | 20) & 0xFu; }
#define XB_SPIN(cond, bar) do { unsigned _sp = 0; while (cond) { __builtin_amdgcn_s_sleep(1); \
    if ((++_sp & 255u) == 0u) { if (xb_ld(&(bar)[XB_TMO])) break; if (_sp > XB_SPIN_CAP) { atomicAdd(&(bar)[XB_TMO], 1u); break; } } } } while (0)
struct XcdBarrier { unsigned* bar; unsigned x; volatile LAS unsigned* st; };
DI XcdBarrier xcd_barrier_post(unsigned* bar, volatile LAS unsigned* st) {
    XcdBarrier b; b.bar = bar; b.x = xb_xcc_id(); b.st = st;
    if (threadIdx.x == 0) (void)xb_add(&bar[XB_XCNT(b.x)], 1u);
    return b;
}
DI void xcd_barrier_complete(unsigned* bar, unsigned x, unsigned& nloc, unsigned& nx) {
    const unsigned G = gridDim.x * gridDim.y * gridDim.z;
    unsigned sum, cnt, mine, sp = 0u;
    for (;;) {
        sum = 0u; cnt = 0u; mine = 0u;
#pragma unroll
        for (unsigned j = 0; j < 16; ++j) { const unsigned c = xb_ld(&bar[XB_XCNT(j)]); sum += c; cnt += (c > 0u) ? 1u : 0u; mine = (j == x) ? c : mine; }
        if (sum == G) break;
        __builtin_amdgcn_s_sleep(1);
        if ((++sp & 255u) == 0u) { if (xb_ld(&bar[XB_TMO])) break; if (sp > XB_SPIN_CAP) { atomicAdd(&bar[XB_TMO], 1u); break; } }
    }
    nloc = mine > 0u ? mine : 1u; nx = cnt > 0u ? cnt : 1u;
}
DI void xcd_barrier(const XcdBarrier& b) {
    asm volatile("s_waitcnt vmcnt(0)" ::: "memory");
    __syncthreads();
    if (threadIdx.x == 0) {
        unsigned* bar = b.bar;
        __builtin_amdgcn_s_waitcnt(0);
        unsigned nloc = b.st[0], nx = b.st[1];
        if (nloc == 0u) { xcd_barrier_complete(bar, b.x, nloc, nx); b.st[0] = nloc; b.st[1] = nx; }
        const unsigned old = xb_add(&bar[XB_XSUB(b.x)], 1u);
        const unsigned gen = old / nloc;
        if (old + 1u == (gen + 1u) * nloc) {
            __builtin_amdgcn_fence(__ATOMIC_RELEASE, "agent");
            asm volatile("s_waitcnt vmcnt(0)" ::: "memory");
            const unsigned og = xb_add(&bar[XB_TOP], 1u);
            const unsigned tg = og / nx;
            if (og + 1u == (tg + 1u) * nx) xb_add(&bar[XB_TOPGEN], 1u);
            else XB_SPIN(xb_ld(&bar[XB_TOPGEN]) == tg, bar);
            __builtin_amdgcn_fence(__ATOMIC_ACQUIRE, "agent");
            xb_add(&bar[XB_XGEN(b.x)], 1u);
            asm volatile("s_waitcnt vmcnt(0)" ::: "memory");
        } else {
            XB_SPIN(xb_ld(&bar[XB_XGEN(b.x)]) == gen, bar);
            __builtin_amdgcn_fence(__ATOMIC_ACQUIRE, "agent");
            asm volatile("s_waitcnt vmcnt(0)" ::: "memory");
        }
    }
    __syncthreads();
}

constexpr int LDS_BYTES = 147456;
constexpr int N_PHASES = 11;

__global__ void __launch_bounds__(512, 2) mk_fwd(Args args) {
    extern __shared__ __attribute__((aligned(16))) unsigned char lds_raw[];
    LAS unsigned char* lds = (LAS unsigned char*)lds_raw;
    const int G = gridDim.x, bx = blockIdx.x;
    const int vcu = (G % 8 == 0) ? (bx % 8) * (G / 8) + bx / 8 : bx;
    const int tid = threadIdx.x, lane = tid & 63, wave = tid >> 6;
    unsigned char* ws = args.ws;
    const int lo = args.ph_lo, hi = args.ph_hi;
    cg::grid_group grid = cg::this_grid();
#define IN(k) (lo <= (k) && (k) < hi)
    volatile LAS unsigned* bst = (volatile LAS unsigned*)(lds + LDS_BYTES - 64);
    if (tid == 0) { bst[0] = 0u; bst[1] = 0u; }
    __syncthreads();
    XcdBarrier xbar = xcd_barrier_post((unsigned*)ws, bst);
#define SEAM(k) do { if (IN(k) && IN((k) + 1)) { if (lo < 0) grid.sync(); else xcd_barrier(xbar); } } while (0)
    float* ssqA = (float*)(ws + WS_SSP); float* ssqB = ssqA + MTOK; float* ssqC = ssqB + MTOK; bf16_t* xb = (bf16_t*)(ws + WS_XB);

    if (IN(0)) phase_prologue(args, lds, vcu, G);
    SEAM(0);
    if (IN(1)) {
        pg8::Gemm g{xb, xb, (const bf16_t*)(ws + WS_WGU1), (const bf16_t*)(ws + WS_WGU1), DM, DM, DM};
        pg8::StaticOrder<false> S; S.init(MTOK, NGU, G, bx);
        EpiGateUp E{(bf16_t*)(ws + WS_HID), ssqA};
        pg8::gemm_phase(lds, g, S, E);
    }
    SEAM(1);
    if (IN(2)) {
        const bf16_t* H = (const bf16_t*)(ws + WS_HID);
        pg8::Gemm g{H, H, (const bf16_t*)(ws + WS_WD1), (const bf16_t*)(ws + WS_WD1), FF, FF, FF};
        pg8::StaticOrder<false> S; S.init(MTOK, DM, G, bx);
        EpiResid<true, false, true> E{nullptr, nullptr, xb, ssqB, 0.5f};
        pg8::gemm_phase(lds, g, S, E);
    }
    SEAM(2);
    if (IN(3)) {
        pg8::Gemm g{xb, xb, (const bf16_t*)(ws + WS_WIN), (const bf16_t*)(ws + WS_WIN), DM, DM, DM};
        pg8::StaticOrder<false> S; S.init(MTOK, NWIN, G, bx);
        EpiWin E{ssqB, (const float*)(ws + WS_ROPE), args.in[I_QNG], args.in[I_KNG], (bf16_t*)(ws + WS_Q), (bf16_t*)(ws + WS_KV), (bf16_t*)(ws + WS_PCU), (bf16_t*)(ws + WS_GB), (bf16_t*)(ws + WS_MG), (float*)(ws + WS_NG)};
        pg8::gemm_phase(lds, g, S, E);
    }
    SEAM(3);
    if (IN(4)) {
        if (vcu < 64) {
            const bf16_t* KVb = (const bf16_t*)(ws + WS_KV);
            pg8::Gemm g{KVb, KVb + KV_SLOT, (const bf16_t*)(ws + WS_WCK1), (const bf16_t*)(ws + WS_WCV1), 1024, 2048, 2048};
            pg8::CmpOrder S{vcu};
            EpiCmp1 E{(const float*)(ws + WS_BIAS1), (bf16_t*)(ws + WS_HC)};
            pg8::gemm_phase(lds, g, S, E);
        } else {
            const int nconv = (G > 64) ? (G - 64) : 0;
            conv_pass(args, (vcu - 64) * 8 + wave, nconv * 8, lane);
        }
    }
    SEAM(4);
    if (IN(5)) cmp2_pass(args, lds, vcu, G);
    SEAM(5);
    if (IN(6)) {
        for (int uix = vcu; uix < 2048; uix += G) {
            const int v = uix & 255, i = uix >> 8, x = v >> 5, k = v & 31, bg = x * 8 + i;
            const int f = (k + 8 * (i >> 1)) & 31, qt = (i & 1) ? 31 - f : f;
            attn_unit(lds, args, bg, qt);
            asm volatile("s_waitcnt lgkmcnt(0)" ::: "memory"); __builtin_amdgcn_s_barrier(); asm volatile("" ::: "memory");
        }
    }
    SEAM(6);
    if (IN(7)) {
        pg8::Gemm g{(const bf16_t*)(ws + WS_AO), (const bf16_t*)(ws + WS_GB), (const bf16_t*)(ws + WS_WA), (const bf16_t*)(ws + WS_WC), 512, 512, 512};
        pg8::StaticOrder<true> S; S.init(MTOK, DM, G, bx);
        EpiMerge E{(const bf16_t*)(ws + WS_MG), (bf16_t*)(ws + WS_MERGED)};
        pg8::gemm_phase(lds, g, S, E);
    }
    SEAM(7);
    if (IN(8)) {
        const bf16_t* Mg = (const bf16_t*)(ws + WS_MERGED);
        pg8::Gemm g{Mg, Mg, (const bf16_t*)(ws + WS_WOUT), (const bf16_t*)(ws + WS_WOUT), DM, DM, DM};
        pg8::StaticOrder<false> S; S.init(MTOK, DM, G, bx);
        EpiResid<true, false, true> E{nullptr, nullptr, xb, ssqC, 1.0f};
        pg8::gemm_phase(lds, g, S, E);
    }
    SEAM(8);
    if (IN(9)) {
        pg8::Gemm g{xb, xb, (const bf16_t*)(ws + WS_WGU2), (const bf16_t*)(ws + WS_WGU2), DM, DM, DM};
        pg8::StaticOrder<false> S; S.init(MTOK, NGU, G, bx);
        EpiGateUp E{(bf16_t*)(ws + WS_HID), ssqC};
        pg8::gemm_phase(lds, g, S, E);
    }
    SEAM(9);
    if (IN(10)) {
        const bf16_t* H = (const bf16_t*)(ws + WS_HID);
        pg8::Gemm g{H, H, (const bf16_t*)(ws + WS_WD2), (const bf16_t*)(ws + WS_WD2), FF, FF, FF};
        pg8::StaticOrder<false> S; S.init(MTOK, DM, G, bx);
        EpiResid<true, true, false> E{nullptr, args.out, xb, nullptr, 0.5f};
        pg8::gemm_phase(lds, g, S, E);
    }
#undef IN
#undef SEAM
}

extern "C" void kernel_launch(void* const* d_in, const int* in_sizes, int n_in, void* d_out, int out_size, void* d_ws, size_t ws_size, hipStream_t stream) {
    static int grid = 0;
    if (grid == 0) {
        if (n_in != 23 || in_sizes[0] != MTOK * DM || out_size != MTOK * DM || ws_size < WS_END) {
            fprintf(stderr, "kernel_launch: unexpected shapes (n_in %d, in0 %d, out %d, ws %zu, need %zu)\n", n_in, n_in > 0 ? in_sizes[0] : -1, out_size, ws_size, (size_t)WS_END); grid = -1; return; }
        int dev = 0, cus = 0;
        if (hipGetDevice(&dev) != hipSuccess || hipDeviceGetAttribute(&cus, hipDeviceAttributeMultiprocessorCount, dev) != hipSuccess) { grid = -1; return; }
        if (hipFuncSetAttribute((const void*)mk_fwd, hipFuncAttributeMaxDynamicSharedMemorySize, LDS_BYTES) != hipSuccess) { fprintf(stderr, "kernel_launch: hipFuncSetAttribute failed\n"); grid = -1; return; }
        int per_cu = 0;
        if (hipOccupancyMaxActiveBlocksPerMultiprocessor(&per_cu, (const void*)mk_fwd, 512, LDS_BYTES) != hipSuccess || per_cu < 1) { fprintf(stderr, "kernel_launch: occupancy query says %d\n", per_cu); (void)hipGetLastError(); }
        grid = cus;
    }
    if (grid < 0) return;
    if (hipMemsetAsync(d_ws, 0, 16384, stream) != hipSuccess) { fprintf(stderr, "kernel_launch: hipMemsetAsync of the barrier words failed\n"); return; }
    Args a{};
    for (int i = 0; i < 23; ++i) a.in[i] = (const float*)d_in[i];
    a.out = (float*)d_out; a.ws = (unsigned char*)d_ws;
#if MK_N_LAUNCHES == 1
    a.ph_lo = 0; a.ph_hi = N_PHASES;
    void* kargs[] = {&a};
    hipError_t e = hipLaunchCooperativeKernel((const void*)mk_fwd, dim3(grid), dim3(512), kargs, LDS_BYTES, stream);
    if (e != hipSuccess) fprintf(stderr, "kernel_launch: cooperative launch failed: %s (grid %d)\n", hipGetErrorString(e), grid);
#else
    for (int p = 0; p < N_PHASES; ++p) {
        a.ph_lo = p; a.ph_hi = p + 1;
        hipLaunchKernelGGL(mk_fwd, dim3(grid), dim3(512), LDS_BYTES, stream, a);
    }
#endif
}
```
